# Optimizing an MI355X kernel written in HIP

```python
import jax, jax.numpy as jnp
from jax import lax
import numpy as np

D_MODEL = 2048
BATCH = 4
SEQ = 4096
DEPTH = 2

HEAD_DIM = 128
ROPE_THETA = 10000.0
NORM_EPS = 1e-6
NEG_INF = -1e30
BLOCK = 128

DIL_GROUPS = ((128, 1), (512, 4), (2048, 16))
DIL_HEADS_PER_GROUP = 4
DIL_HEADS = DIL_HEADS_PER_GROUP * len(DIL_GROUPS)
DIL_OUT = DIL_HEADS_PER_GROUP * HEAD_DIM

NSA_Q_HEADS = 16
NSA_KV_HEADS = 2
NSA_REP = NSA_Q_HEADS // NSA_KV_HEADS
CMP_LEN = 32
CMP_STRIDE = 16
CMP_HIDDEN = 256
SEL_LEN = 64
SEL_TOPK = 16
SEL_CHUNK = 64
WIN_LEN = 512
N_NSA_BRANCH = 3
FORCE_BONUS = 1e4

D_FF = -(-8 * D_MODEL // (3 * 256)) * 256

COLS = (DIL_HEADS * HEAD_DIM, DIL_HEADS * HEAD_DIM, DIL_HEADS * HEAD_DIM,
        NSA_Q_HEADS * HEAD_DIM,
        NSA_KV_HEADS * HEAD_DIM, NSA_KV_HEADS * HEAD_DIM,
        NSA_KV_HEADS * HEAD_DIM, NSA_KV_HEADS * HEAD_DIM,
        NSA_KV_HEADS * HEAD_DIM, NSA_KV_HEADS * HEAD_DIM,
        NSA_Q_HEADS * N_NSA_BRANCH, D_MODEL, D_MODEL)
N_IN = sum(COLS)

kernel_name = "hybrid_dilated_nsa_gated_block"


def rms_norm(x, g):
    xf = x.astype(jnp.float32)
    y = xf * lax.rsqrt(jnp.mean(xf * xf, axis=-1, keepdims=True) + NORM_EPS)
    return (y * g.astype(jnp.float32)).astype(x.dtype)


def rope(x, pos):
    half = HEAD_DIM // 2
    inv = ROPE_THETA ** (-2.0 * jnp.arange(half, dtype=jnp.float32) / HEAD_DIM)
    ang = pos.astype(jnp.float32)[..., None] * inv
    cos = jnp.cos(ang)[:, :, None, :]
    sin = jnp.sin(ang)[:, :, None, :]
    xf = x.astype(jnp.float32)
    x1, x2 = xf[..., :half], xf[..., half:]
    return jnp.concatenate([x1 * cos - x2 * sin, x2 * cos + x1 * sin], axis=-1).astype(x.dtype)


def banded_attention(q, k, v, max_dist):
    B, S, G, R, dh = q.shape
    nb = S // BLOCK
    nprev = -(-max_dist // BLOCK)
    pad = nprev * BLOCK
    kp = jnp.pad(k, ((0, 0), (pad, 0), (0, 0), (0, 0))).reshape(B, nb + nprev, BLOCK, G, dh)
    vp = jnp.pad(v, ((0, 0), (pad, 0), (0, 0), (0, 0))).reshape(B, nb + nprev, BLOCK, G, dh)
    kb = jnp.concatenate([kp[:, i:i + nb] for i in range(nprev + 1)], axis=2)
    vb = jnp.concatenate([vp[:, i:i + nb] for i in range(nprev + 1)], axis=2)
    qb = q.reshape(B, nb, BLOCK, G, R, dh)
    s = jnp.einsum('bnqgrd,bnkgd->bngrqk', qb, kb).astype(jnp.float32) * (dh ** -0.5)
    kb_len = (nprev + 1) * BLOCK
    qi = jnp.arange(BLOCK)[:, None]
    kk = jnp.arange(kb_len)[None, :]
    dist = pad + qi - kk
    kabs = jnp.arange(nb)[:, None, None] * BLOCK - pad + kk[None]
    mask = (dist >= 0)[None] & (dist <= max_dist)[None] & (kabs >= 0)
    s = jnp.where(mask[None, :, None, None], s, NEG_INF)
    m = jnp.max(s, axis=-1, keepdims=True)
    p = jnp.exp(s - m)
    l = jnp.sum(p, axis=-1, keepdims=True)
    o = jnp.einsum('bngrqk,bnkgd->bnqgrd', (p / l).astype(v.dtype), vb)
    lse = (m + jnp.log(l))[..., 0]
    lse = jnp.transpose(lse, (0, 1, 4, 2, 3)).reshape(B, S, G, R)
    return o.reshape(B, S, G, R, dh), lse


def dilated_window_attention(q, k, v, window, dilation):
    B, S, H, dh = q.shape
    unit = dilation * BLOCK
    Sp = -(-S // unit) * unit
    L = Sp // dilation

    def fold(t):
        t = jnp.pad(t, ((0, 0), (0, Sp - S), (0, 0), (0, 0)))
        return t.reshape(B, L, dilation, H, dh).transpose(0, 2, 1, 3, 4).reshape(B * dilation, L, H, dh)

    o, lse = banded_attention(fold(q)[:, :, :, None, :], fold(k), fold(v), window // dilation)
    o = o[:, :, :, 0].reshape(B, dilation, L, H, dh).transpose(0, 2, 1, 3, 4).reshape(B, Sp, H, dh)[:, :S]
    lse = lse[:, :, :, 0].reshape(B, dilation, L, H).transpose(0, 2, 1, 3).reshape(B, Sp, H)[:, :S]
    return o.astype(jnp.float32), lse


def compress_blocks(t, pos_emb, w1, w2):
    B, S, G, dh = t.shape
    n_c = (S - CMP_LEN) // CMP_STRIDE + 1
    idx = jnp.arange(n_c)[:, None] * CMP_STRIDE + jnp.arange(CMP_LEN)[None, :]
    blk = t[:, idx] + pos_emb[None, None, :, None, :]
    blk = jnp.transpose(blk, (0, 1, 3, 2, 4)).reshape(B, n_c, G, CMP_LEN * dh)
    return jax.nn.gelu(blk @ w1) @ w2


def nsa_attention(q, kc, vc, ks, vs, kw, vw, gates, positions,
                  cmp_pos_k, cmp_pos_v, cmp_w1_k, cmp_w2_k, cmp_w1_v, cmp_w2_v):
    B, S, G, R, dh = q.shape
    scale = dh ** -0.5
    t = jnp.arange(S)

    n_c = (S - CMP_LEN) // CMP_STRIDE + 1
    blk_end = jnp.arange(n_c) * CMP_STRIDE + CMP_LEN - 1
    k_cmp = rope(compress_blocks(kc, cmp_pos_k, cmp_w1_k, cmp_w2_k), positions[:, blk_end])
    v_cmp = compress_blocks(vc, cmp_pos_v, cmp_w1_v, cmp_w2_v)
    s = jnp.einsum('bsgrd,bcgd->bgrsc', q, k_cmp).astype(jnp.float32) * scale
    valid_c = blk_end[None, :] <= t[:, None]
    s = jnp.where(valid_c, s, NEG_INF)
    m = jnp.max(s, axis=-1, keepdims=True)
    p = jnp.where(valid_c, jnp.exp(s - m), 0.0)
    p = p / jnp.maximum(jnp.sum(p, axis=-1, keepdims=True), 1e-30)
    o_cmp = jnp.einsum('bgrsc,bcgd->bsgrd', p.astype(vc.dtype), v_cmp)

    n_s = S // SEL_LEN
    n_sel = min(SEL_TOPK, n_s)
    c_start = jnp.arange(n_c) * CMP_STRIDE
    s_start = jnp.arange(n_s) * SEL_LEN
    overlap = ((c_start[:, None] <= s_start[None, :] + SEL_LEN - 1) &
               (c_start[:, None] + CMP_LEN - 1 >= s_start[None, :])).astype(jnp.float32)
    p_slc = jnp.einsum('bgsc,cj->bsgj', jnp.sum(p, axis=2), overlap)
    blk_t = t // SEL_LEN
    j = jnp.arange(n_s)
    valid_s = j[None, :] <= blk_t[:, None]
    forced = (j[None, :] == 0) | (j[None, :] == blk_t[:, None]) | (j[None, :] == blk_t[:, None] - 1)
    score = jnp.where(valid_s[None, :, None, :],
                      p_slc + jnp.where(forced, FORCE_BONUS, 0.0)[None, :, None, :], -1.0)
    _, sel_idx = lax.top_k(score, n_sel)

    kblk = ks.reshape(B, n_s, SEL_LEN, G, dh).transpose(0, 3, 1, 2, 4)
    vblk = vs.reshape(B, n_s, SEL_LEN, G, dh).transpose(0, 3, 1, 2, 4)
    bi = jnp.arange(B)[:, None, None, None]
    gi = jnp.arange(G)[None, None, :, None]
    nch = S // SEL_CHUNK

    def sel_chunk(args):
        q_c, idx_c, t_c = args
        k_sel = kblk[bi, gi, idx_c]
        v_sel = vblk[bi, gi, idx_c]
        sc = jnp.einsum('bqgrd,bqgnld->bqgrnl', q_c, k_sel).astype(jnp.float32) * scale
        kpos = idx_c[..., None] * SEL_LEN + jnp.arange(SEL_LEN)
        ok = kpos <= t_c[None, :, None, None, None]
        sc = jnp.where(ok[:, :, :, None], sc, NEG_INF)
        shp = sc.shape
        pr = jax.nn.softmax(sc.reshape(shp[:4] + (shp[4] * shp[5],)), axis=-1).reshape(shp)
        return jnp.einsum('bqgrnl,bqgnld->bqgrd', pr.astype(v_sel.dtype), v_sel)

    q_chunks = q.reshape(B, nch, SEL_CHUNK, G, R, dh).swapaxes(0, 1)
    i_chunks = sel_idx.reshape(B, nch, SEL_CHUNK, G, n_sel).swapaxes(0, 1)
    t_chunks = t.reshape(nch, SEL_CHUNK)
    o_slc = lax.map(sel_chunk, (q_chunks, i_chunks, t_chunks))
    o_slc = o_slc.swapaxes(0, 1).reshape(B, S, G, R, dh)

    o_win, _ = banded_attention(q, kw, vw, WIN_LEN - 1)

    o = (gates[..., 0:1] * o_cmp.astype(jnp.float32) +
         gates[..., 1:2] * o_slc.astype(jnp.float32) +
         gates[..., 2:3] * o_win.astype(jnp.float32))
    return o.astype(q.dtype)


def hybrid_layer(x, positions, ln_mix, w_in, cmp_pos_k, cmp_pos_v, cmp_w1_k, cmp_w2_k,
                 cmp_w1_v, cmp_w2_v, w_out_a, w_out_b, w_out, ln_ffn,
                 w_ffn_gate, w_ffn_up, w_ffn_down):
    B, S, _ = x.shape
    dh = HEAD_DIM
    h = rms_norm(x, ln_mix)
    proj = h @ w_in
    offs = [int(o) for o in np.cumsum(COLS)[:-1]]
    (qa, ka, va, qb, kc, vc, ks, vs, kw, vw,
     gate_b, gate_a_merge, gate_b_merge) = jnp.split(proj, offs, axis=-1)

    qa = rope(qa.reshape(B, S, DIL_HEADS, dh), positions)
    ka = rope(ka.reshape(B, S, DIL_HEADS, dh), positions)
    va = va.reshape(B, S, DIL_HEADS, dh)
    outs, lses = [], []
    for gi_, (win, dil) in enumerate(DIL_GROUPS):
        sl = slice(gi_ * DIL_HEADS_PER_GROUP, (gi_ + 1) * DIL_HEADS_PER_GROUP)
        o_g, lse_g = dilated_window_attention(qa[:, :, sl], ka[:, :, sl], va[:, :, sl], win, dil)
        outs.append(o_g)
        lses.append(lse_g)
    wts = jax.nn.softmax(jnp.stack(lses, axis=0), axis=0)
    ya = jnp.sum(wts[..., None] * jnp.stack(outs, axis=0), axis=0).astype(x.dtype)
    ya = ya.reshape(B, S, DIL_OUT) @ w_out_a

    G, R = NSA_KV_HEADS, NSA_REP
    qb = rope(qb.reshape(B, S, NSA_Q_HEADS, dh), positions).reshape(B, S, G, R, dh)
    kv = lambda t_: t_.reshape(B, S, G, dh)
    gates = jax.nn.sigmoid(gate_b.astype(jnp.float32)).reshape(B, S, G, R, N_NSA_BRANCH)
    yb = nsa_attention(qb, kv(kc), kv(vc), rope(kv(ks), positions), kv(vs),
                       rope(kv(kw), positions), kv(vw), gates, positions,
                       cmp_pos_k, cmp_pos_v, cmp_w1_k, cmp_w2_k, cmp_w1_v, cmp_w2_v)
    yb = yb.reshape(B, S, NSA_Q_HEADS * dh) @ w_out_b

    ga = jax.nn.sigmoid(gate_a_merge.astype(jnp.float32))
    gb = jax.nn.sigmoid(gate_b_merge.astype(jnp.float32))
    y = (ga * ya.astype(jnp.float32) + gb * yb.astype(jnp.float32)).astype(x.dtype)
    x = x + y @ w_out

    h2 = rms_norm(x, ln_ffn)
    x = x + (jax.nn.silu(h2 @ w_ffn_gate) * (h2 @ w_ffn_up)) @ w_ffn_down
    return x


def setup_inputs(seed: int = 0) -> dict:
    key = jax.random.key(seed)
    k = jax.random.split(key, 20)
    f32 = jnp.float32
    nrm = lambda kk, shape, fan_in: jax.random.normal(kk, shape, f32) * (fan_in ** -0.5)
    L = DEPTH
    return {
        "x": jax.random.normal(k[0], (BATCH, SEQ, D_MODEL), f32),
        "positions": jnp.broadcast_to(jnp.arange(SEQ, dtype=jnp.int32), (BATCH, SEQ)),
        "ln_mix": 1.0 + 0.02 * jax.random.normal(k[1], (L, D_MODEL), f32),
        "w_in": nrm(k[2], (L, D_MODEL, N_IN), D_MODEL),
        "cmp_pos_k": 0.02 * jax.random.normal(k[3], (L, CMP_LEN, HEAD_DIM), f32),
        "cmp_pos_v": 0.02 * jax.random.normal(k[4], (L, CMP_LEN, HEAD_DIM), f32),
        "cmp_w1_k": nrm(k[5], (L, CMP_LEN * HEAD_DIM, CMP_HIDDEN), CMP_LEN * HEAD_DIM),
        "cmp_w2_k": nrm(k[6], (L, CMP_HIDDEN, HEAD_DIM), CMP_HIDDEN),
        "cmp_w1_v": nrm(k[7], (L, CMP_LEN * HEAD_DIM, CMP_HIDDEN), CMP_LEN * HEAD_DIM),
        "cmp_w2_v": nrm(k[8], (L, CMP_HIDDEN, HEAD_DIM), CMP_HIDDEN),
        "w_out_a": nrm(k[9], (L, DIL_OUT, D_MODEL), DIL_OUT),
        "w_out_b": nrm(k[10], (L, NSA_Q_HEADS * HEAD_DIM, D_MODEL), NSA_Q_HEADS * HEAD_DIM),
        "w_out": nrm(k[11], (L, D_MODEL, D_MODEL), D_MODEL),
        "ln_ffn": 1.0 + 0.02 * jax.random.normal(k[12], (L, D_MODEL), f32),
        "w_ffn_gate": nrm(k[13], (L, D_MODEL, D_FF), D_MODEL),
        "w_ffn_up": nrm(k[14], (L, D_MODEL, D_FF), D_MODEL),
        "w_ffn_down": nrm(k[15], (L, D_FF, D_MODEL), D_FF),
        "ln_final": 1.0 + 0.02 * jax.random.normal(k[16], (D_MODEL,), f32),
    }


def reference(x, positions, ln_mix, w_in, cmp_pos_k, cmp_pos_v, cmp_w1_k, cmp_w2_k,
              cmp_w1_v, cmp_w2_v, w_out_a, w_out_b, w_out, ln_ffn,
              w_ffn_gate, w_ffn_up, w_ffn_down, ln_final):
    for l in range(DEPTH):
        x = hybrid_layer(x, positions, ln_mix[l], w_in[l], cmp_pos_k[l], cmp_pos_v[l],
                         cmp_w1_k[l], cmp_w2_k[l], cmp_w1_v[l], cmp_w2_v[l],
                         w_out_a[l], w_out_b[l], w_out[l], ln_ffn[l],
                         w_ffn_gate[l], w_ffn_up[l], w_ffn_down[l])
    return rms_norm(x, ln_final)
```

```cpp
#include <hip/hip_runtime.h>
#include <hip/hip_cooperative_groups.h>
#include <cstdio>
#include <cstdint>
namespace cg = cooperative_groups;

#define PROBE_A -1
#define PROBE_B -1
#define N_PROBE ((PROBE_A >= 0 ? 1 : 0) + (PROBE_B >= 0 ? 1 : 0))
#ifndef MULTI_LAUNCH
#define MULTI_LAUNCH 0
#endif

typedef unsigned short u16;
typedef __attribute__((ext_vector_type(8))) short bf16x8;
typedef __attribute__((ext_vector_type(4))) short s16x4;
typedef __attribute__((ext_vector_type(4))) float f32x4;
typedef __attribute__((ext_vector_type(16))) float f32x16;
typedef __attribute__((ext_vector_type(2))) float f32x2_t;
typedef __attribute__((ext_vector_type(2))) __bf16 bf16x2_t;

#define DI __device__ __forceinline__
#define MFMA32(a, b, c) __builtin_amdgcn_mfma_f32_32x32x16_bf16((a), (b), (c), 0, 0, 0)

constexpr int T_ = 16384, S_ = 4096, NB_ = 4, D_ = 2048, NIN = 12336, PS = 12352, NINP = 12544, DFF = 5632;
constexpr int C_QA = 0, C_KA = 1536, C_VA = 3072, C_QB = 4608, C_KC = 6656, C_VC = 6912, C_KS = 7168, C_VS = 7424,
              C_KW = 7680, C_VW = 7936, C_GA = 8192, C_GB = 10240, C_GN = 12288;
constexpr float SCALE = 0.08838834764831845f;
constexpr float NEG = -1e30f;
constexpr int NTHREADS = 512;
constexpr int VSTRIDE = 288;
constexpr int VTILE_B = 32 * VSTRIDE;

constexpr size_t OFF_WIN_T = 0;
constexpr size_t OFF_PSUM = OFF_WIN_T;
constexpr size_t OFF_YA = OFF_WIN_T + 33554432;
constexpr size_t OFF_WOA_T = OFF_WIN_T + (size_t)NINP * 2048 * 2;
constexpr size_t OFF_WOB_T = OFF_WOA_T + (size_t)2048 * 512 * 2;
constexpr size_t OFF_WO_T = OFF_WOB_T + (size_t)2048 * 2048 * 2;
constexpr size_t OFF_W1K_T = OFF_WO_T + (size_t)2048 * 2048 * 2;
constexpr size_t OFF_W1V_T = OFF_W1K_T + (size_t)256 * 4096 * 2;
constexpr size_t OFF_W2K_T = OFF_W1V_T + (size_t)256 * 4096 * 2;
constexpr size_t OFF_W2V_T = OFF_W2K_T + (size_t)128 * 256 * 2;
constexpr size_t OFF_PROJ = OFF_W2V_T + (size_t)128 * 256 * 2;
constexpr size_t OFF_R2 = OFF_PROJ + (size_t)T_ * PS * 2;
constexpr size_t OFF_R3 = OFF_R2 + (size_t)T_ * 2048 * 2;
constexpr size_t OFF_YB = OFF_R3 + (size_t)T_ * 2048 * 2;
constexpr size_t OFF_OG = OFF_YB + (size_t)T_ * 2048 * 2;
constexpr size_t OFF_LSE = OFF_OG + (size_t)3 * T_ * 512 * 2;
constexpr size_t OFF_WGU_T = OFF_YB;
constexpr size_t OFF_WD_T = OFF_WGU_T + (size_t)11264 * 2048 * 2;
constexpr size_t OFF_CS = OFF_LSE + (size_t)3 * T_ * 4 * 4;
constexpr size_t OFF_KCMP = OFF_CS + (size_t)T_ * 64 * 8;
constexpr size_t OFF_VCMP = OFF_KCMP + (size_t)4 * 256 * 2 * 128 * 2;
constexpr size_t OFF_KV4 = OFF_VCMP + (size_t)4 * 256 * 2 * 128 * 2;
constexpr size_t OFF_BAR = OFF_KV4 + (size_t)4 * T_ * 2 * 128 * 2;
constexpr size_t WS_END = OFF_BAR + 8192;
static_assert(OFF_WD_T + (size_t)2048 * 5632 * 2 <= OFF_CS, "ffn weight alias overflow");
static_assert(OFF_YA + (size_t)T_ * 512 * 2 <= OFF_WOA_T, "ya alias overflow");

struct Params {
  const float* x; const int* pos; const float* ln_mix; const float* w_in; const float* cpk; const float* cpv;
  const float* w1k; const float* w2k; const float* w1v; const float* w2v; const float* woa; const float* wob;
  const float* wo; const float* ln_ffn; const float* wg; const float* wu; const float* wd; const float* ln_final;
  float* out; char* ws;
};

__shared__ __attribute__((aligned(16))) char smem[147456];

DI unsigned pk2(float a, float b) {
  f32x2_t v = {a, b};
  bf16x2_t r = __builtin_convertvector(v, bf16x2_t);
  return __builtin_bit_cast(unsigned, r);
}
DI float bf2f(u16 b) { return __uint_as_float(((unsigned)b) << 16); }
DI float bflo(unsigned w) { return __uint_as_float(w << 16); }
DI float bfhi(unsigned w) { return __uint_as_float(w & 0xffff0000u); }
DI u16 f2bf(float a) { return (u16)(pk2(a, 0.f) & 0xffffu); }
DI bf16x8 ldg8(const u16* p) { return *reinterpret_cast<const bf16x8*>(p); }
DI float wave_sum(float v) {
#pragma unroll
  for (int o = 32; o >= 1; o >>= 1) v += __shfl_xor(v, o);
  return v;
}
DI float sigmoidf_(float v) { return 1.f / (1.f + __expf(-v)); }
DI int crow(int i, int h) { return (i & 3) + 8 * (i >> 2) + 4 * h; }
DI f32x16 zero16() { f32x16 z;
#pragma unroll
  for (int i = 0; i < 16; ++i) z[i] = 0.f; return z; }
DI bf16x8 pack8(const f32x16& x, int s) {
  unsigned w0 = pk2(x[8 * s + 0], x[8 * s + 1]), w1 = pk2(x[8 * s + 2], x[8 * s + 3]);
  unsigned w2 = pk2(x[8 * s + 4], x[8 * s + 5]), w3 = pk2(x[8 * s + 6], x[8 * s + 7]);
  typedef __attribute__((ext_vector_type(4))) unsigned u32x4;
  u32x4 p = {w0, w1, w2, w3};
  return __builtin_bit_cast(bf16x8, p);
}

template <class SRC>
DI void tconv(u16* __restrict__ dst, int K, int Npad, int ldsrc, SRC src, int bid, int nb, int tid) {
  float* tile = (float*)smem;
  const int nk = K / 128, nn = Npad / 128, ntile = nk * nn;
  float4 v[8];
  auto load_tile = [&](int t) {
    const int kt = t % nk, nt = t / nk, k0 = kt * 128, n0 = nt * 128;
#pragma unroll
    for (int e = 0; e < 8; ++e) {
      const int idx = tid + 512 * e, kk = idx >> 5, n4 = (idx & 31) * 4;
      const float* cp = src(n0 + n4);
      v[e] = cp ? *reinterpret_cast<const float4*>(cp + (size_t)(k0 + kk) * ldsrc) : make_float4(0.f, 0.f, 0.f, 0.f);
    }
  };
  if (bid < ntile) load_tile(bid);
  for (int t = bid; t < ntile; t += nb) {
    const int kt = t % nk, nt = t / nk, k0 = kt * 128, n0 = nt * 128;
#pragma unroll
    for (int e = 0; e < 8; ++e) {
      const int idx = tid + 512 * e, kk = idx >> 5, n4 = (idx & 31) * 4;
      float* tp = tile + kk * 129 + n4;
      tp[0] = v[e].x; tp[1] = v[e].y; tp[2] = v[e].z; tp[3] = v[e].w;
    }
    if (t + nb < ntile) load_tile(t + nb);
    __syncthreads();
#pragma unroll
    for (int e = 0; e < 4; ++e) {
      const int c = tid + 512 * e;
      const int nl = (c & 7) + 8 * (c >> 7), kc = ((c >> 3) & 15) * 8;
      const float* tp = tile + kc * 129 + nl;
      uint4 w;
      w.x = pk2(tp[0 * 129], tp[1 * 129]);
      w.y = pk2(tp[2 * 129], tp[3 * 129]);
      w.z = pk2(tp[4 * 129], tp[5 * 129]);
      w.w = pk2(tp[6 * 129], tp[7 * 129]);
      *reinterpret_cast<uint4*>(dst + (size_t)(n0 + nl) * K + k0 + kc) = w;
    }
    __syncthreads();
  }
}

DI void conv_w1frag(u16* __restrict__ dst, const float* __restrict__ w1, int gtid, int nthr) {
  for (int it = gtid; it < 8 * 256 * 64; it += nthr) {
    const int ln = it & 63, ks = (it >> 6) & 255, nbk = it >> 14;
    const float* sp = w1 + (size_t)(16 * ks + 8 * (ln >> 5)) * 256 + 32 * nbk + (ln & 31);
    uint4 w;
    w.x = pk2(sp[0 * 256], sp[1 * 256]); w.y = pk2(sp[2 * 256], sp[3 * 256]);
    w.z = pk2(sp[4 * 256], sp[5 * 256]); w.w = pk2(sp[6 * 256], sp[7 * 256]);
    *reinterpret_cast<uint4*>(dst + (size_t)it * 8) = w;
  }
}

DI void rmsnorm_bf16(const float* __restrict__ x, const float* __restrict__ g, u16* __restrict__ h, int gw, int nw, int lane) {
  for (int row = gw; row < T_; row += nw) {
    const float4* xr = reinterpret_cast<const float4*>(x + (size_t)row * D_);
    float4 v[8];
    float ss = 0.f;
#pragma unroll
    for (int i = 0; i < 8; ++i) { v[i] = xr[lane + 64 * i]; ss += v[i].x * v[i].x + v[i].y * v[i].y + v[i].z * v[i].z + v[i].w * v[i].w; }
    ss = wave_sum(ss);
    const float rs = rsqrtf(ss * (1.f / 2048.f) + 1e-6f);
    uint2* hr = reinterpret_cast<uint2*>(h + (size_t)row * D_);
#pragma unroll
    for (int i = 0; i < 8; ++i) {
      const float4 gg = reinterpret_cast<const float4*>(g)[lane + 64 * i];
      uint2 o;
      o.x = pk2(v[i].x * rs * gg.x, v[i].y * rs * gg.y);
      o.y = pk2(v[i].z * rs * gg.z, v[i].w * rs * gg.w);
      hr[lane + 64 * i] = o;
    }
  }
}
DI void rmsnorm_f32_inplace(float* __restrict__ x, const float* __restrict__ g, int gw, int nw, int lane) {
  for (int row = gw; row < T_; row += nw) {
    float4* xr = reinterpret_cast<float4*>(x + (size_t)row * D_);
    float4 v[8];
    float ss = 0.f;
#pragma unroll
    for (int i = 0; i < 8; ++i) { v[i] = xr[lane + 64 * i]; ss += v[i].x * v[i].x + v[i].y * v[i].y + v[i].z * v[i].z + v[i].w * v[i].w; }
    ss = wave_sum(ss);
    const float rs = rsqrtf(ss * (1.f / 2048.f) + 1e-6f);
#pragma unroll
    for (int i = 0; i < 8; ++i) {
      const float4 gg = reinterpret_cast<const float4*>(g)[lane + 64 * i];
      float4 o;
      o.x = v[i].x * rs * gg.x; o.y = v[i].y * rs * gg.y; o.z = v[i].z * rs * gg.z; o.w = v[i].w * rs * gg.w;
      xr[lane + 64 * i] = o;
    }
  }
}

constexpr int BM = 256, BK = 64, HALF = 128, NXCD = 8, WGM = 8, HT = HALF * BK;

DI int lds_byte(int r, int c) {
  int st = (r >> 4) * 2 + (c >> 5), rr = r & 15, cc = c & 31, ob = rr * 64 + cc * 2;
  return st * 1024 + (ob ^ (((ob >> 9) & 1) << 5));
}
DI void stage_rc(int b, int& R, int& C) {
  int st = b / 1024, sb = b % 1024, swz = sb ^ (((sb >> 9) & 1) << 5);
  R = (st >> 1) * 16 + swz / 64; C = (st & 1) * 32 + (swz % 64) / 2;
}

typedef f32x4 GemmAcc[2][2][4][2];

DI void gemm_kloop(const u16* __restrict__ A, const u16* __restrict__ Bt, const int K, const int brow, const int bcol, GemmAcc& acc, const int tid) {
  u16* shm = reinterpret_cast<u16*>(smem);
#define SA(b, h) (shm + ((b) * 2 + (h)) * HT)
#define SB(b, h) (shm + (4 + (b) * 2 + (h)) * HT)
#define STAGE(P, BASE, br, kt) do { const unsigned _ub = (unsigned)(((br) * K + (kt) * BK) * 2); \
    __builtin_amdgcn_global_load_lds((const unsigned*)((const char*)(BASE) + (size_t)(_ub + so0)), \
        (unsigned*)((char*)(P) + tid * 16), 16, 0, 0); \
    __builtin_amdgcn_global_load_lds((const unsigned*)((const char*)(BASE) + (size_t)(_ub + so1)), \
        (unsigned*)((char*)(P) + tid * 16 + 8192), 16, 0, 0); } while (0)
#define LDA(dst, b, h) for (int m = 0; m < 4; ++m) for (int k = 0; k < 2; ++k) \
    dst[m][k] = *reinterpret_cast<const bf16x8*>((char*)SA(b, h) + aoff + m * 2048 + k * 1024)
#define LDB(dst, b, h) for (int n = 0; n < 2; ++n) for (int k = 0; k < 2; ++k) \
    dst[n][k] = *reinterpret_cast<const bf16x8*>((char*)SB(b, h) + boff + n * 2048 + k * 1024)
#define MMA(ai, bj, At, Bt_) do { __builtin_amdgcn_s_setprio(1); \
    for (int m = 0; m < 4; ++m) for (int n = 0; n < 2; ++n) for (int k = 0; k < 2; ++k) \
      acc[ai][bj][m][n] = __builtin_amdgcn_mfma_f32_16x16x32_bf16(Bt_[n][k], At[m][k], acc[ai][bj][m][n], 0, 0, 0); \
    __builtin_amdgcn_s_setprio(0); } while (0)
#define WAIT_V(n) asm volatile("s_waitcnt vmcnt(" #n ")" ::: "memory")
#define WAIT_L(n) asm volatile("s_waitcnt lgkmcnt(" #n ")" ::: "memory")
#define BAR __builtin_amdgcn_s_barrier()
#define SCHED __builtin_amdgcn_sched_barrier(0)
  const int wid = tid >> 6, lane = tid & 63, wr = wid >> 2, wc = wid & 3, fr = lane & 15, fq = lane >> 4;
  bf16x8 At[4][2], B0[2][2], B1[2][2];
  unsigned so0, so1;
  { int r0, c0; stage_rc(tid * 16, r0, c0); so0 = (unsigned)((r0 * K + c0) * 2); so1 = so0 + (unsigned)(64 * K * 2); }
  const int lanepart = lds_byte(fr, fq * 8);
  const int aoff = wr * 8192 + lanepart, boff = wc * 4096 + lanepart;
  const int nt = K / BK;
  STAGE(SB(0, 0), Bt, bcol, 0); STAGE(SA(0, 0), A, brow, 0);
  STAGE(SB(0, 1), Bt, bcol + HALF, 0); STAGE(SA(0, 1), A, brow + HALF, 0);
  if (wr == 1) BAR;
  WAIT_V(4); BAR;
  STAGE(SB(1, 0), Bt, bcol, 1); STAGE(SA(1, 0), A, brow, 1); STAGE(SB(1, 1), Bt, bcol + HALF, 1);
  WAIT_V(6); BAR;
  for (int t = 0; t < nt - 2; t += 2) {
    LDB(B0, 0, 0); SCHED; LDA(At, 0, 0); STAGE(SA(1, 1), A, brow + HALF, t + 1);
    WAIT_L(8); BAR; WAIT_L(0); MMA(0, 0, At, B0); BAR; SCHED;
    LDB(B1, 0, 1); STAGE(SB(0, 0), Bt, bcol, t + 2);
    BAR; WAIT_L(0); MMA(0, 1, At, B1); BAR;
    LDA(At, 0, 1); STAGE(SA(0, 0), A, brow, t + 2);
    BAR; WAIT_L(0); MMA(1, 0, At, B0); BAR; SCHED;
    STAGE(SB(0, 1), Bt, bcol + HALF, t + 2);
    WAIT_V(6); BAR; MMA(1, 1, At, B1); BAR;
    LDB(B0, 1, 0); SCHED; LDA(At, 1, 0); STAGE(SA(0, 1), A, brow + HALF, t + 2);
    WAIT_L(8); BAR; WAIT_L(0); MMA(0, 0, At, B0); BAR; SCHED;
    LDB(B1, 1, 1); STAGE(SB(1, 0), Bt, bcol, t + 3);
    BAR; WAIT_L(0); MMA(0, 1, At, B1); BAR;
    LDA(At, 1, 1); STAGE(SA(1, 0), A, brow, t + 3);
    BAR; WAIT_L(0); MMA(1, 0, At, B0); BAR; SCHED;
    STAGE(SB(1, 1), Bt, bcol + HALF, t + 3);
    WAIT_V(6); BAR; MMA(1, 1, At, B1); BAR;
  }
  { LDB(B0, 0, 0); LDA(At, 0, 0); STAGE(SA(1, 1), A, brow + HALF, nt - 1);
    BAR; WAIT_L(0); MMA(0, 0, At, B0); BAR;
    LDB(B1, 0, 1); BAR; WAIT_L(0); MMA(0, 1, At, B1); BAR;
    LDA(At, 0, 1); WAIT_V(4); BAR; WAIT_L(0); MMA(1, 0, At, B0); MMA(1, 1, At, B1); BAR; }
  { LDB(B0, 1, 0); LDA(At, 1, 0); WAIT_V(2); BAR; WAIT_L(0); MMA(0, 0, At, B0); BAR;
    LDB(B1, 1, 1); WAIT_V(0); BAR; WAIT_L(0); MMA(0, 1, At, B1); BAR;
    LDA(At, 1, 1); BAR; WAIT_L(0); MMA(1, 0, At, B0); MMA(1, 1, At, B1); BAR; }
  if (wr == 0) BAR;
}

#define PAIR(BR1, BC1, T1, BR2, BC2, T2, T3) \
    LDB(B0, 0, 0); SCHED; LDA(At, 0, 0); STAGE(SA(1, 1), A, (BR1) + HALF, T1); \
    WAIT_L(8); BAR; WAIT_L(0); MMA(0, 0, At, B0); BAR; SCHED; \
    LDB(B1, 0, 1); STAGE(SB(0, 0), Bt, BC2, T2); \
    BAR; WAIT_L(0); MMA(0, 1, At, B1); BAR; \
    LDA(At, 0, 1); STAGE(SA(0, 0), A, BR2, T2); \
    BAR; WAIT_L(0); MMA(1, 0, At, B0); BAR; SCHED; \
    STAGE(SB(0, 1), Bt, (BC2) + HALF, T2); \
    WAIT_V(6); BAR; MMA(1, 1, At, B1); BAR; \
    LDB(B0, 1, 0); SCHED; LDA(At, 1, 0); STAGE(SA(0, 1), A, (BR2) + HALF, T2); \
    WAIT_L(8); BAR; WAIT_L(0); MMA(0, 0, At, B0); BAR; SCHED; \
    LDB(B1, 1, 1); STAGE(SB(1, 0), Bt, BC2, T3); \
    BAR; WAIT_L(0); MMA(0, 1, At, B1); BAR; \
    LDA(At, 1, 1); STAGE(SA(1, 0), A, BR2, T3); \
    BAR; WAIT_L(0); MMA(1, 0, At, B0); BAR; SCHED; \
    STAGE(SB(1, 1), Bt, (BC2) + HALF, T3); \
    WAIT_V(6); BAR; MMA(1, 1, At, B1); BAR;

__device__ __forceinline__ void gemm_tile_coords(int id, int nM, int nN, int& pm, int& pn);

template <class EPI>
DI void gemm_stream(const u16* __restrict__ A, const u16* __restrict__ Bt, const int K, const int nM, const int nN,
                    const int bid, const int nb, const int tid, EPI epi) {
  const int ntot = nM * nN;
  if (bid >= ntot) return;
  u16* shm = reinterpret_cast<u16*>(smem);
  const int wid = tid >> 6, lane = tid & 63, wr = wid >> 2, wc = wid & 3, fr = lane & 15, fq = lane >> 4;
  unsigned so0, so1;
  { int r0, c0; stage_rc(tid * 16, r0, c0); so0 = (unsigned)((r0 * K + c0) * 2); so1 = so0 + (unsigned)(64 * K * 2); }
  const int lanepart = lds_byte(fr, fq * 8);
  const int aoff = wr * 8192 + lanepart, boff = wc * 4096 + lanepart;
  const int nt = K / BK;
  int pm, pn; gemm_tile_coords(bid, nM, nN, pm, pn);
  int brow = pm * BM, bcol = pn * BM;
  GemmAcc acc = {};
  STAGE(SB(0, 0), Bt, bcol, 0); STAGE(SA(0, 0), A, brow, 0);
  STAGE(SB(0, 1), Bt, bcol + HALF, 0); STAGE(SA(0, 1), A, brow + HALF, 0);
  if (wr == 1) BAR;
  WAIT_V(4); BAR;
  STAGE(SB(1, 0), Bt, bcol, 1); STAGE(SA(1, 0), A, brow, 1); STAGE(SB(1, 1), Bt, bcol + HALF, 1);
  WAIT_V(6); BAR;
  for (int id = bid; id < ntot; id += nb) {
    const int idn = id + nb;
    int pm2 = pm, pn2 = pn;
    if (idn < ntot) gemm_tile_coords(idn, nM, nN, pm2, pn2);
    const int brow2 = pm2 * BM, bcol2 = pn2 * BM;
    for (int t = 0; t < nt; t += 2) {
      const bool inside = (t + 2 < nt);
      const int brs = inside ? brow : brow2, bcs = inside ? bcol : bcol2, t2 = inside ? t + 2 : 0;
      bf16x8 At[4][2], B0[2][2], B1[2][2];
      PAIR(brow, bcol, t + 1, brs, bcs, t2, t2 + 1)
    }
    epi(acc, brow, bcol, pn);
#pragma unroll
    for (int ai = 0; ai < 2; ++ai)
#pragma unroll
      for (int bj = 0; bj < 2; ++bj)
#pragma unroll
        for (int m = 0; m < 4; ++m)
#pragma unroll
          for (int n = 0; n < 2; ++n) acc[ai][bj][m][n] = (f32x4){0.f, 0.f, 0.f, 0.f};
    brow = brow2; bcol = bcol2; pm = pm2; pn = pn2;
  }
  WAIT_V(0);
  if (wr == 0) BAR;
  BAR;
}

DI void gemm_tile_coords(int id, int nM, int nN, int& pm, int& pn) {
  const int nwg = nM * nN;
  int q = nwg / NXCD, r = nwg % NXCD, xcd = id % NXCD, off = id / NXCD;
  int wgid = (xcd < r ? xcd * (q + 1) : r * (q + 1) + (xcd - r) * q) + off;
  int nig = WGM * nN, gid = wgid / nig, fm = gid * WGM, gsz = min(nM - fm, WGM);
  pm = fm + ((wgid % nig) % gsz); pn = (wgid % nig) / gsz;
}

#define ACC_FOREACH _Pragma("unroll") for (int ai = 0; ai < 2; ++ai) _Pragma("unroll") for (int bj = 0; bj < 2; ++bj) _Pragma("unroll") for (int m = 0; m < 4; ++m) _Pragma("unroll") for (int n = 0; n < 2; ++n)
#define ACC_ROW (brow + ai * HALF + wr * 64 + m * 16 + fr)
#define ACC_COL (bcol + bj * HALF + wc * 32 + n * 16 + fq * 4)
#define GEMM_IDS int tid_ = tid; asm volatile("" : "+v"(tid_)); const int wid = tid_ >> 6, lane = tid_ & 63, wr = wid >> 2, wc = wid & 3, fr = lane & 15, fq = lane >> 4; (void)lane;
#define EPI_SCHED __builtin_amdgcn_sched_barrier(0)

DI void gemm_proj(const Params& p, int bid, int nb, int tid) {
  const u16* A = (const u16*)(p.ws + OFF_R2);
  const u16* Bt = (const u16*)(p.ws + OFF_WIN_T);
  u16* C = (u16*)(p.ws + OFF_PROJ);
  const int nM = T_ / BM, nN = NINP / BM;
  gemm_stream(A, Bt, 2048, nM, nN, bid, nb, tid, [&](GemmAcc& acc, const int brow, const int bcol, const int pn) {
    GEMM_IDS
    const bool rope_tile = (pn < 12) || (pn >= 18 && pn < 26) || pn == 28 || pn == 30;
    const bool kv_tile = (pn >= 28 && pn < 32);
    const int d1 = wc * 16 + fq * 4;
    const float* cs = (const float*)(p.ws + OFF_CS);
#pragma unroll
    for (int ai = 0; ai < 2; ++ai) {
      float4 c01[4], c23[4];
#pragma unroll
      for (int m = 0; m < 4; ++m) {
        const int row = brow + ai * HALF + wr * 64 + m * 16 + fr;
        c01[m] = make_float4(1.f, 0.f, 1.f, 0.f); c23[m] = c01[m];
        if (rope_tile) {
          c01[m] = *reinterpret_cast<const float4*>(cs + ((size_t)row * 64 + d1) * 2);
          c23[m] = *reinterpret_cast<const float4*>(cs + ((size_t)row * 64 + d1) * 2 + 4);
        }
      }
#pragma unroll
      for (int m = 0; m < 4; ++m) {
        const int row = brow + ai * HALF + wr * 64 + m * 16 + fr;
#pragma unroll
        for (int bj = 0; bj < 2; ++bj) {
          const f32x4 x1 = acc[ai][bj][m][0], x2 = acc[ai][bj][m][1];
          uint2 w1, w2;
          w1.x = pk2(x1[0] * c01[m].x - x2[0] * c01[m].y, x1[1] * c01[m].z - x2[1] * c01[m].w);
          w1.y = pk2(x1[2] * c23[m].x - x2[2] * c23[m].y, x1[3] * c23[m].z - x2[3] * c23[m].w);
          w2.x = pk2(x2[0] * c01[m].x + x1[0] * c01[m].y, x2[1] * c01[m].z + x1[1] * c01[m].w);
          w2.y = pk2(x2[2] * c23[m].x + x1[2] * c23[m].y, x2[3] * c23[m].z + x1[3] * c23[m].w);
          const int col1 = bcol + bj * HALF + d1;
          if (kv_tile) {
            u16* dk = (u16*)(p.ws + OFF_KV4) + ((size_t)((((pn - 28) * 4 + (row >> 12)) * 2 + bj) * 4096 + (row & 4095))) * 128 + d1;
            *reinterpret_cast<uint2*>(dk) = w1;
            *reinterpret_cast<uint2*>(dk + 64) = w2;
          } else {
            if (col1 < PS) *reinterpret_cast<uint2*>(C + (size_t)row * PS + col1) = w1;
            if (col1 + 64 < PS) *reinterpret_cast<uint2*>(C + (size_t)row * PS + col1 + 64) = w2;
          }
        }
      }
      EPI_SCHED;
    }
  });
}

DI void gemm_merge(const Params& p, int bid, int nb, int tid) {
  const u16* A1 = (const u16*)(p.ws + OFF_YA);
  const u16* B1 = (const u16*)(p.ws + OFF_WOA_T);
  const u16* A2 = (const u16*)(p.ws + OFF_YB);
  const u16* B2 = (const u16*)(p.ws + OFF_WOB_T);
  const u16* proj = (const u16*)(p.ws + OFF_PROJ);
  u16* C = (u16*)(p.ws + OFF_R3);
  const int nM = T_ / BM, nN = 2048 / BM;
  for (int id = bid; id < nM * nN; id += nb) {
    int pm, pn; gemm_tile_coords(id, nM, nN, pm, pn);
    const int brow = pm * BM, bcol = pn * BM;
    GemmAcc acc = {};
    gemm_kloop(A1, B1, 512, brow, bcol, acc, tid);
    {
    GEMM_IDS
#pragma unroll
    for (int ai = 0; ai < 2; ++ai)
#pragma unroll
      for (int bj = 0; bj < 2; ++bj) {
        uint2 gw[4][2];
#pragma unroll
        for (int m = 0; m < 4; ++m)
#pragma unroll
          for (int n = 0; n < 2; ++n) gw[m][n] = *reinterpret_cast<const uint2*>(proj + (size_t)ACC_ROW * PS + C_GA + ACC_COL);
#pragma unroll
        for (int m = 0; m < 4; ++m)
#pragma unroll
          for (int n = 0; n < 2; ++n) {
            f32x4& v = acc[ai][bj][m][n];
            uint2 w;
            w.x = pk2(v[0] * sigmoidf_(bflo(gw[m][n].x)), v[1] * sigmoidf_(bfhi(gw[m][n].x)));
            w.y = pk2(v[2] * sigmoidf_(bflo(gw[m][n].y)), v[3] * sigmoidf_(bfhi(gw[m][n].y)));
            *reinterpret_cast<uint2*>(C + (size_t)ACC_ROW * 2048 + ACC_COL) = w;
            v[0] = 0.f; v[1] = 0.f; v[2] = 0.f; v[3] = 0.f;
          }
        EPI_SCHED;
      }
    }
    gemm_kloop(A2, B2, 2048, brow, bcol, acc, tid);
    GEMM_IDS
#pragma unroll
    for (int ai = 0; ai < 2; ++ai)
#pragma unroll
      for (int bj = 0; bj < 2; ++bj) {
        uint2 gw[4][2], old[4][2];
#pragma unroll
        for (int m = 0; m < 4; ++m)
#pragma unroll
          for (int n = 0; n < 2; ++n) {
            gw[m][n] = *reinterpret_cast<const uint2*>(proj + (size_t)ACC_ROW * PS + C_GB + ACC_COL);
            old[m][n] = *reinterpret_cast<const uint2*>(C + (size_t)ACC_ROW * 2048 + ACC_COL);
          }
#pragma unroll
        for (int m = 0; m < 4; ++m)
#pragma unroll
          for (int n = 0; n < 2; ++n) {
            const f32x4 v = acc[ai][bj][m][n];
            uint2 w;
            w.x = pk2(bflo(old[m][n].x) + v[0] * sigmoidf_(bflo(gw[m][n].x)), bfhi(old[m][n].x) + v[1] * sigmoidf_(bfhi(gw[m][n].x)));
            w.y = pk2(bflo(old[m][n].y) + v[2] * sigmoidf_(bflo(gw[m][n].y)), bfhi(old[m][n].y) + v[3] * sigmoidf_(bfhi(gw[m][n].y)));
            *reinterpret_cast<uint2*>(C + (size_t)ACC_ROW * 2048 + ACC_COL) = w;
          }
        EPI_SCHED;
      }
  }
}

DI void gemm_resid(const u16* A, const u16* Bt, int K, const float* xin, float* xout, int bid, int nb, int tid) {
  const int nM = T_ / BM, nN = 2048 / BM;
  gemm_stream(A, Bt, K, nM, nN, bid, nb, tid, [&](GemmAcc& acc, const int brow, const int bcol, const int pn) {
    (void)pn;
    GEMM_IDS
#pragma unroll
    for (int ai = 0; ai < 2; ++ai)
#pragma unroll
      for (int bj = 0; bj < 2; ++bj) {
        float4 xi[4][2];
#pragma unroll
        for (int m = 0; m < 4; ++m)
#pragma unroll
          for (int n = 0; n < 2; ++n) xi[m][n] = *reinterpret_cast<const float4*>(xin + (size_t)ACC_ROW * 2048 + ACC_COL);
#pragma unroll
        for (int m = 0; m < 4; ++m)
#pragma unroll
          for (int n = 0; n < 2; ++n) {
            const f32x4 v = acc[ai][bj][m][n];
            float4 r; r.x = xi[m][n].x + v[0]; r.y = xi[m][n].y + v[1]; r.z = xi[m][n].z + v[2]; r.w = xi[m][n].w + v[3];
            *reinterpret_cast<float4*>(xout + (size_t)ACC_ROW * 2048 + ACC_COL) = r;
          }
        EPI_SCHED;
      }
  });
}

DI void gemm_gateup(const Params& p, int bid, int nb, int tid) {
  const u16* A = (const u16*)(p.ws + OFF_R2);
  const u16* Bt = (const u16*)(p.ws + OFF_WGU_T);
  u16* C = (u16*)(p.ws + OFF_PROJ);
  const int nM = T_ / BM, nN = 11264 / BM;
  gemm_stream(A, Bt, 2048, nM, nN, bid, nb, tid, [&](GemmAcc& acc, const int brow, const int bcol, const int pn) {
    (void)bcol;
    GEMM_IDS
    _Pragma("unroll") for (int ai = 0; ai < 2; ++ai) _Pragma("unroll") for (int m = 0; m < 4; ++m) _Pragma("unroll") for (int n = 0; n < 2; ++n) {
      const int col = pn * 128 + wc * 32 + n * 16 + fq * 4;
      const int row = brow + ai * HALF + wr * 64 + m * 16 + fr;
      const f32x4 g = acc[ai][0][m][n], uu = acc[ai][1][m][n];
      uint2 w;
      w.x = pk2(g[0] * sigmoidf_(g[0]) * uu[0], g[1] * sigmoidf_(g[1]) * uu[1]);
      w.y = pk2(g[2] * sigmoidf_(g[2]) * uu[2], g[3] * sigmoidf_(g[3]) * uu[3]);
      *reinterpret_cast<uint2*>(C + (size_t)row * DFF + col) = w;
      EPI_SCHED;
    }
  });
}

struct AttnAcc { f32x16 o[4]; float m, l; };
DI void attn_init(AttnAcc& a) {
#pragma unroll
  for (int c = 0; c < 4; ++c) a.o[c] = zero16();
  a.m = NEG; a.l = 0.f;
}
DI f32x16 qk_tile(const bf16x8 (&qf)[8], const u16* kp) {
  bf16x8 kf[8];
#pragma unroll
  for (int s = 0; s < 8; ++s) kf[s] = ldg8(kp + 16 * s);
  f32x16 st = zero16();
#pragma unroll
  for (int s = 0; s < 8; ++s) st = MFMA32(kf[s], qf[s], st);
  return st;
}
template <int B>
DI void tr_read8(unsigned addr, s16x4 (&r)[8]) {
  asm volatile("ds_read_b64_tr_b16 %0, %8 offset:%9\n\tds_read_b64_tr_b16 %1, %8 offset:%10\n\t"
               "ds_read_b64_tr_b16 %2, %8 offset:%11\n\tds_read_b64_tr_b16 %3, %8 offset:%12\n\t"
               "ds_read_b64_tr_b16 %4, %8 offset:%13\n\tds_read_b64_tr_b16 %5, %8 offset:%14\n\t"
               "ds_read_b64_tr_b16 %6, %8 offset:%15\n\tds_read_b64_tr_b16 %7, %8 offset:%16\n\ts_waitcnt lgkmcnt(0)"
               : "=&v"(r[0]), "=&v"(r[1]), "=&v"(r[2]), "=&v"(r[3]), "=&v"(r[4]), "=&v"(r[5]), "=&v"(r[6]), "=&v"(r[7])
               : "v"(addr), "i"(B), "i"(8 * VSTRIDE + B), "i"(16 * VSTRIDE + B), "i"(24 * VSTRIDE + B),
                 "i"(B + 64), "i"(8 * VSTRIDE + B + 64), "i"(16 * VSTRIDE + B + 64), "i"(24 * VSTRIDE + B + 64)
               : "memory");
}
template <int C>
DI void pv_block2(f32x16& oa, f32x16& ob, unsigned vbase, const bf16x8& pf0, const bf16x8& pf1) {
  s16x4 r[8];
  tr_read8<64 * C>(vbase, r);
  const bf16x8 a0 = __builtin_shufflevector(r[0], r[1], 0, 1, 2, 3, 4, 5, 6, 7);
  const bf16x8 a1 = __builtin_shufflevector(r[2], r[3], 0, 1, 2, 3, 4, 5, 6, 7);
  const bf16x8 b0 = __builtin_shufflevector(r[4], r[5], 0, 1, 2, 3, 4, 5, 6, 7);
  const bf16x8 b1 = __builtin_shufflevector(r[6], r[7], 0, 1, 2, 3, 4, 5, 6, 7);
  oa = MFMA32(a0, pf0, oa);
  ob = MFMA32(b0, pf0, ob);
  oa = MFMA32(a1, pf1, oa);
  ob = MFMA32(b1, pf1, ob);
}
template <class VR>
DI void v_stage(VR vrow, char* vlds, int lane) {
  bf16x8 vst[8];
#pragma unroll
  for (int i = 0; i < 8; ++i) { const int nn = lane + 64 * i; vst[i] = ldg8(vrow(nn >> 4) + 8 * (nn & 15)); }
#pragma unroll
  for (int i = 0; i < 8; ++i) { const int nn = lane + 64 * i; *reinterpret_cast<bf16x8*>(vlds + VSTRIDE * (nn >> 4) + 16 * (nn & 15)) = vst[i]; }
}
DI unsigned v_base(char* vlds, int lane) {
  const int h = lane >> 5, blk = (lane >> 4) & 1, q = (lane & 15) >> 2, pp = lane & 3;
  return (unsigned)(size_t)vlds + VSTRIDE * (4 * h + q) + 32 * blk + 8 * pp;
}
DI void pv_tile(AttnAcc& a, const f32x16& pr, char* vlds, int lane) {
  const bf16x8 pf0 = pack8(pr, 0), pf1 = pack8(pr, 1);
  const unsigned vb = v_base(vlds, lane);
  asm volatile("s_waitcnt lgkmcnt(0)" ::: "memory");
  pv_block2<0>(a.o[0], a.o[1], vb, pf0, pf1);
  pv_block2<2>(a.o[2], a.o[3], vb, pf0, pf1);
}
template <class VR, class MK>
DI void attn_tile(AttnAcc& a, const bf16x8 (&qf)[8], const u16* kp, VR vrow, MK mask, char* vlds, int lane) {
  const int h = lane >> 5;
  f32x16 st = qk_tile(qf, kp);
  v_stage(vrow, vlds, lane);
  float mx = a.m;
#pragma unroll
  for (int i = 0; i < 16; ++i) {
    const float sv = mask(crow(i, h)) ? st[i] * SCALE : NEG;
    st[i] = sv; mx = fmaxf(mx, sv);
  }
  mx = fmaxf(mx, __shfl_xor(mx, 32));
  const float alpha = __expf(a.m - mx);
  a.m = mx;
  float ls = 0.f;
#pragma unroll
  for (int i = 0; i < 16; ++i) { const float pv = (st[i] > -1e29f) ? __expf(st[i] - mx) : 0.f; st[i] = pv; ls += pv; }
  a.l = a.l * alpha + ls;
#pragma unroll
  for (int c = 0; c < 4; ++c) a.o[c] *= alpha;
  pv_tile(a, st, vlds, lane);
}
DI void store_col(const AttnAcc& a, float sc, u16* dst, int h) {
#pragma unroll
  for (int c = 0; c < 4; ++c)
#pragma unroll
    for (int g4 = 0; g4 < 4; ++g4) {
      uint2 w;
      w.x = pk2(a.o[c][4 * g4 + 0] * sc, a.o[c][4 * g4 + 1] * sc);
      w.y = pk2(a.o[c][4 * g4 + 2] * sc, a.o[c][4 * g4 + 3] * sc);
      *reinterpret_cast<uint2*>(dst + 32 * c + 8 * g4 + 4 * h) = w;
    }
}

DI f32x16 qk_tile_lds(const bf16x8 (&qf)[8], const char* kr);
DI void cols_to_lds(const AttnAcc& a, float sc, char* tl, int lane) {
  asm volatile("" : "+v"(lane));
  const int u = lane & 31, h = lane >> 5;
#pragma unroll
  for (int c = 0; c < 4; ++c)
#pragma unroll
    for (int g4 = 0; g4 < 4; ++g4) {
      uint2 w;
      w.x = pk2(a.o[c][4 * g4 + 0] * sc, a.o[c][4 * g4 + 1] * sc);
      w.y = pk2(a.o[c][4 * g4 + 2] * sc, a.o[c][4 * g4 + 3] * sc);
      *reinterpret_cast<uint2*>(tl + u * 256 + (((4 * c + g4) ^ (u & 15)) << 4) + 8 * h) = w;
    }
  asm volatile("s_waitcnt lgkmcnt(0)" ::: "memory");
}
DI uint4 lds_row_chunk(const char* tl, int row, int chunk) {
  asm volatile("" : "+v"(row), "+v"(chunk));
  return *reinterpret_cast<const uint4*>(tl + row * 256 + ((chunk ^ (row & 15)) << 4));
}

DI void tile_compute32(AttnAcc& a, const bf16x8 (&qf)[8], const char* Kl, char* Vl, const int lo, const int hi, int lane) {
  const int u = lane & 31, h = lane >> 5;
  f32x16 st = qk_tile_lds(qf, Kl + u * 272 + 16 * h);
  constexpr float C2 = SCALE * 1.4426950408889634f;
  const bool empty = lo > hi;
  const unsigned span = empty ? 0u : (unsigned)(hi - lo);
  const int lo3 = empty ? (1 << 20) : lo - 4 * h;
  float mx = a.m;
#pragma unroll
  for (int i = 0; i < 16; ++i) {
    const int vc = (i & 3) + 8 * (i >> 2);
    const bool ok = (unsigned)(vc - lo3) <= span;
    const float sv = ok ? st[i] * C2 : NEG;
    st[i] = sv; mx = fmaxf(mx, sv);
  }
  mx = fmaxf(mx, __shfl_xor(mx, 32));
  const float msafe = (mx == NEG) ? 0.f : mx;
  const float alpha = __builtin_amdgcn_exp2f(a.m - msafe);
  a.m = mx;
  float ls = 0.f;
#pragma unroll
  for (int i = 0; i < 16; ++i) { const float pv = __builtin_amdgcn_exp2f(st[i] - msafe); st[i] = pv; ls += pv; }
  a.l = a.l * alpha + ls;
#pragma unroll
  for (int c = 0; c < 4; ++c) a.o[c] *= alpha;
  pv_tile(a, st, Vl, lane);
}

DI void dil_item(const Params& p, int item, char* wlds, int lane) {
  const u16* proj = (const u16*)(p.ws + OFF_PROJ);
  const int b = item / 1536, rem = item % 1536, head = rem >> 7, ti = rem & 127;
  const int gi = head >> 2, hh = head & 3;
  const int r = (gi == 0) ? 1 : (gi == 1 ? 4 : 16);
  const int tpc = (S_ / r) / 32;
  const int cres = ti / tpc, i0 = (ti % tpc) * 32;
  const int u = lane & 31, h = lane >> 5;
  const size_t tokbase = (size_t)b * S_;
  const int tq = r * (i0 + u) + cres;
  char* Kl = wlds;
  char* Vl = wlds + 32 * 272;
  bf16x8 qf[8];
  {
    const u16* qp = proj + (tokbase + tq) * PS + C_QA + head * 128 + 8 * h;
#pragma unroll
    for (int s = 0; s < 8; ++s) qf[s] = ldg8(qp + 16 * s);
  }
  const int srow = lane >> 4, sch = lane & 15;
  const int kt0 = (i0 >= 128) ? 0 : (128 - i0) >> 5;
  bf16x8 kst[8], vst[8];
  auto load_tile = [&](int kt) {
    const int kb = i0 - 128 + 32 * kt;
#pragma unroll
    for (int i = 0; i < 8; ++i) {
      int ii = kb + srow + 4 * i; ii = ii < 0 ? 0 : ii;
      const u16* rp = proj + (tokbase + (size_t)(r * ii + cres)) * PS + head * 128 + sch * 8;
      kst[i] = ldg8(rp + C_KA);
      vst[i] = ldg8(rp + C_VA);
    }
  };
  load_tile(kt0);
  AttnAcc a; attn_init(a);
  for (int kt = kt0; kt < 5; ++kt) {
#pragma unroll
    for (int i = 0; i < 8; ++i) {
      *reinterpret_cast<bf16x8*>(Kl + (srow + 4 * i) * 272 + sch * 16) = kst[i];
      *reinterpret_cast<bf16x8*>(Vl + (srow + 4 * i) * VSTRIDE + sch * 16) = vst[i];
    }
    if (kt + 1 < 5) load_tile(kt + 1);
    const int kb = i0 - 128 + 32 * kt;
    const int qi = i0 + u;
    int lo_ = qi - 128 - kb; if (lo_ < -kb) lo_ = -kb; if (lo_ < 0) lo_ = 0;
    int hi_ = qi - kb; if (hi_ > 31) hi_ = 31;
    tile_compute32(a, qf, Kl, Vl, lo_, hi_, lane);
  }
  const float lt = a.l + __shfl_xor(a.l, 32);
  cols_to_lds(a, 1.f / lt, Kl, lane);
  {
    u16* ogb = (u16*)(p.ws + OFF_OG) + ((size_t)gi * T_ + tokbase) * 512 + hh * 128;
#pragma unroll
    for (int i = 0; i < 8; ++i) {
      const int row = srow + 4 * i;
      const uint4 v = lds_row_chunk(Kl, row, sch);
      *reinterpret_cast<uint4*>(ogb + (size_t)(r * (i0 + row) + cres) * 512 + sch * 8) = v;
    }
  }
  if (h == 0) ((float*)(p.ws + OFF_LSE))[((size_t)gi * T_ + tokbase + tq) * 4 + hh] = a.m * 0.6931471805599453f + __logf(lt);
}

constexpr int CMP_KL = 256 * 272;
DI f32x16 qk_tile_lds(const bf16x8 (&qf)[8], const char* kr) {
  bf16x8 kf[8];
#pragma unroll
  for (int s = 0; s < 8; ++s) kf[s] = *reinterpret_cast<const bf16x8*>(kr + 32 * s);
  f32x16 st = zero16();
#pragma unroll
  for (int s = 0; s < 8; ++s) st = MFMA32(kf[s], qf[s], st);
  return st;
}
DI void cmp_block(const Params& p, int sit, int tid, int wid, int lane) {
  const u16* proj = (const u16*)(p.ws + OFF_PROJ);
  const u16* kcmp = (const u16*)(p.ws + OFF_KCMP);
  const u16* vcmp = (const u16*)(p.ws + OFF_VCMP);
  float* psum = (float*)(p.ws + OFF_PSUM);
  const int bg = sit & 7, slot = sit >> 3, b = bg >> 1, g = bg & 1;
  char* Kl = smem;
  char* Vl = smem + CMP_KL;
  __syncthreads();
  {
    bf16x8 tmp[8];
#pragma unroll
    for (int e = 0; e < 8; ++e) { const int idx = tid + 512 * e; tmp[e] = ldg8(kcmp + ((size_t)(b * 256 + (idx >> 4)) * 2 + g) * 128 + (idx & 15) * 8); }
#pragma unroll
    for (int e = 0; e < 8; ++e) { const int idx = tid + 512 * e; *reinterpret_cast<bf16x8*>(Kl + (idx >> 4) * 272 + (idx & 15) * 16) = tmp[e]; }
#pragma unroll
    for (int e = 0; e < 8; ++e) { const int idx = tid + 512 * e; tmp[e] = ldg8(vcmp + ((size_t)(b * 256 + (idx >> 4)) * 2 + g) * 128 + (idx & 15) * 8); }
#pragma unroll
    for (int e = 0; e < 8; ++e) { const int idx = tid + 512 * e; *reinterpret_cast<bf16x8*>(Vl + (idx >> 4) * VSTRIDE + (idx & 15) * 16) = tmp[e]; }
  }
  __syncthreads();
  const int u = lane & 31, h = lane >> 5, tl = u >> 3, rr = u & 7;
  const size_t tokbase = (size_t)b * S_;
  for (int qq = 0; qq < 4; ++qq) {
    const int q = qq == 0 ? slot : (qq == 1 ? 63 - slot : (qq == 2 ? 64 + slot : 127 - slot));
    const int t0 = 32 * q + 4 * wid;
    const int tq = t0 + tl, head = g * 8 + rr;
    bf16x8 qf[8];
    {
      const u16* qp = proj + (tokbase + tq) * PS + C_QB + head * 128 + 8 * h;
#pragma unroll
      for (int s = 0; s < 8; ++s) qf[s] = ldg8(qp + 16 * s);
    }
    const int nv = tq >= 31 ? ((tq - 31) >> 4) + 1 : 0;
    const int nvmax = (t0 + 3) >= 31 ? ((t0 + 3 - 31) >> 4) + 1 : 0;
    const int ntile = (nvmax + 31) >> 5;
    float mrun = NEG, lrun = 0.f;
    for (int kt = 0; kt < ntile; ++kt) {
      f32x16 st = qk_tile_lds(qf, Kl + (32 * kt + u) * 272 + 16 * h);
      float mx = mrun;
#pragma unroll
      for (int i = 0; i < 16; ++i) {
        const float sv = (32 * kt + crow(i, h) < nv) ? st[i] * SCALE : NEG;
        st[i] = sv; mx = fmaxf(mx, sv);
      }
      mx = fmaxf(mx, __shfl_xor(mx, 32));
      float ls = 0.f;
#pragma unroll
      for (int i = 0; i < 16; ++i) ls += (st[i] > -1e29f) ? __expf(st[i] - mx) : 0.f;
      lrun = lrun * __expf(mrun - mx) + ls;
      mrun = mx;
    }
    const float lt = lrun + __shfl_xor(lrun, 32);
    const float inv = 1.f / fmaxf(lt, 1e-30f);
    AttnAcc a; attn_init(a);
    float* psrow = psum + ((tokbase + tq) * 2 + g) * 256;
    for (int kt = 0; kt < ntile; ++kt) {
      f32x16 st = qk_tile_lds(qf, Kl + (32 * kt + u) * 272 + 16 * h);
      float psv[16];
#pragma unroll
      for (int i = 0; i < 16; ++i) {
        const bool ok = (32 * kt + crow(i, h) < nv);
        const float pv = ok ? __expf(st[i] * SCALE - mrun) * inv : 0.f;
        st[i] = pv;
        float ps = pv;
        ps += __shfl_xor(ps, 1); ps += __shfl_xor(ps, 2); ps += __shfl_xor(ps, 4);
        psv[i] = ps;
      }
      if (rr == 0) {
#pragma unroll
        for (int g4 = 0; g4 < 4; ++g4)
          *reinterpret_cast<float4*>(psrow + 32 * kt + 8 * g4 + 4 * h) = make_float4(psv[4 * g4], psv[4 * g4 + 1], psv[4 * g4 + 2], psv[4 * g4 + 3]);
      }
      pv_tile(a, st, Vl + 32 * kt * VSTRIDE, lane);
    }
    for (int kt = ntile; kt < 8; ++kt) {
      if (rr == 0) {
#pragma unroll
        for (int g4 = 0; g4 < 4; ++g4) *reinterpret_cast<float4*>(psrow + 32 * kt + 8 * g4 + 4 * h) = make_float4(0.f, 0.f, 0.f, 0.f);
      }
    }
    {
      uint2* of = reinterpret_cast<uint2*>(p.ws + OFF_R2) + ((((size_t)(b * 2 + g) * 128 + q) * 8 + wid) * 16) * 64 + lane;
#pragma unroll
      for (int c = 0; c < 4; ++c)
#pragma unroll
        for (int g4 = 0; g4 < 4; ++g4) {
          uint2 w;
          w.x = pk2(a.o[c][4 * g4 + 0], a.o[c][4 * g4 + 1]);
          w.y = pk2(a.o[c][4 * g4 + 2], a.o[c][4 * g4 + 3]);
          of[(c * 4 + g4) * 64] = w;
        }
    }
  }
  __syncthreads();
}

constexpr int KSTR = 272;
constexpr int STG_K = 64 * KSTR;
constexpr int STG_B = STG_K + 64 * VSTRIDE;
constexpr int LDS_UNION = 2 * STG_B;

DI void coop_compute(AttnAcc& a, const bf16x8 (&qf)[8], char* stg, const int lo, const int hi, int lane) {
  const int u = lane & 31, h = lane >> 5;
  f32x16 st[2];
#pragma unroll
  for (int hf = 0; hf < 2; ++hf) {
    const char* kr = stg + (32 * hf + u) * KSTR + 16 * h;
    bf16x8 kf[8];
#pragma unroll
    for (int s = 0; s < 8; ++s) kf[s] = *reinterpret_cast<const bf16x8*>(kr + 32 * s);
    st[hf] = zero16();
#pragma unroll
    for (int s = 0; s < 8; ++s) st[hf] = MFMA32(kf[s], qf[s], st[hf]);
  }
  constexpr float C2 = SCALE * 1.4426950408889634f;
  const bool full = (lo <= 0) && (hi >= 63), empty = lo > hi;
  float mx = a.m;
  if (__all(full || empty)) {
    const float cs = full ? C2 : 0.f, ad = full ? 0.f : NEG;
#pragma unroll
    for (int hf = 0; hf < 2; ++hf)
#pragma unroll
      for (int i = 0; i < 16; ++i) { const float sv = fmaf(st[hf][i], cs, ad); st[hf][i] = sv; mx = fmaxf(mx, sv); }
  } else {
    const unsigned span = empty ? 0u : (unsigned)(hi - lo);
    const int lo3 = empty ? (1 << 20) : lo - 4 * h;
#pragma unroll
    for (int hf = 0; hf < 2; ++hf)
#pragma unroll
      for (int i = 0; i < 16; ++i) {
        const int vc = 32 * hf + (i & 3) + 8 * (i >> 2);
        const bool ok = (unsigned)(vc - lo3) <= span;
        const float sv = ok ? st[hf][i] * C2 : NEG;
        st[hf][i] = sv; mx = fmaxf(mx, sv);
      }
  }
  mx = fmaxf(mx, __shfl_xor(mx, 32));
  const float msafe = (mx == NEG) ? 0.f : mx;
  const float alpha = __builtin_amdgcn_exp2f(a.m - msafe);
  a.m = mx;
  float ls = 0.f;
#pragma unroll
  for (int hf = 0; hf < 2; ++hf)
#pragma unroll
    for (int i = 0; i < 16; ++i) { const float pv = __builtin_amdgcn_exp2f(st[hf][i] - msafe); st[hf][i] = pv; ls += pv; }
  a.l = a.l * alpha + ls;
  if (!__all(alpha == 1.f)) {
#pragma unroll
    for (int c = 0; c < 4; ++c) a.o[c] *= alpha;
  }
  pv_tile(a, st[0], stg + STG_K, lane);
  pv_tile(a, st[1], stg + STG_K + 32 * VSTRIDE, lane);
}

template <class NEED, class MK>
DI void coop_attn(AttnAcc& a, const bf16x8 (&qf)[8], const u16* __restrict__ Kg, const u16* __restrict__ Vg,
                  unsigned long long blkmask, NEED need, MK mask, int tid, int lane) {
  if (!blkmask) return;
  const int r0 = tid >> 4, ch = tid & 15;
  const int ko = r0 * KSTR + ch * 16, vo = STG_K + r0 * VSTRIDE + ch * 16;
#define CA_POP(dst) do { if (blkmask) { dst = __builtin_ctzll(blkmask); blkmask &= blkmask - 1; } else dst = -1; } while (0)
#define CA_LOAD(S, jj) do { const size_t go_ = (size_t)(64 * (jj) + r0) * 128 + ch * 8; \
    S##0 = ldg8(Kg + go_); S##1 = ldg8(Kg + go_ + 32 * 128); S##2 = ldg8(Vg + go_); S##3 = ldg8(Vg + go_ + 32 * 128); } while (0)
#define CA_STORE(S, st_) do { char* s_ = (st_); *reinterpret_cast<bf16x8*>(s_ + ko) = S##0; *reinterpret_cast<bf16x8*>(s_ + ko + 32 * KSTR) = S##1; \
    *reinterpret_cast<bf16x8*>(s_ + vo) = S##2; *reinterpret_cast<bf16x8*>(s_ + vo + 32 * VSTRIDE) = S##3; } while (0)
#define CA_STEP(LD, ST) { CA_POP(j2); if (j2 >= 0) CA_LOAD(LD, j2); \
    if (need(j)) { int lo_, hi_; mask(j, lo_, hi_); coop_compute(a, qf, smem + cur * STG_B, lo_, hi_, lane); } \
    if (j1 >= 0) CA_STORE(ST, smem + (cur ^ 1) * STG_B); \
    __syncthreads(); \
    if (j1 < 0) break; \
    j = j1; j1 = j2; cur ^= 1; }
  bf16x8 A0, A1, A2, A3, B0, B1, B2, B3;
  int j, j1, j2, cur = 0;
  CA_POP(j); CA_POP(j1);
  CA_LOAD(A, j);
  CA_STORE(A, smem);
  if (j1 >= 0) CA_LOAD(A, j1);
  __syncthreads();
  for (;;) {
    CA_STEP(B, A)
    CA_STEP(A, B)
  }
#undef CA_POP
#undef CA_LOAD
#undef CA_STORE
#undef CA_STEP
}
DI const u16* kv4(const Params& p, int tensor, int b, int g) {
  return (const u16*)(p.ws + OFF_KV4) + (size_t)((tensor * 4 + b) * 2 + g) * 4096 * 128;
}

DI void win_block(const Params& p, int it, int tid, int wid, int lane) {
  const u16* proj = (const u16*)(p.ws + OFF_PROJ);
  const int q = it >> 3, bg = it & 7, b = bg >> 1, g = bg & 1, t0 = 32 * q;
  const int u = lane & 31, h = lane >> 5;
  const int hd = 8 * g + wid, t = t0 + u;
  const size_t tok = (size_t)b * S_ + t;
  bf16x8 qf[8];
  {
    const u16* qp = proj + tok * PS + C_QB + hd * 128 + 8 * h;
#pragma unroll
    for (int s = 0; s < 8; ++s) qf[s] = ldg8(qp + 16 * s);
  }
  const int lo = (t0 - 511 > 0 ? t0 - 511 : 0) >> 6, hi = (t0 + 31) >> 6;
  const unsigned long long blkmask = ((~0ull) >> (63 - hi)) & ((~0ull) << lo);
  AttnAcc a; attn_init(a);
  coop_attn(a, qf, kv4(p, 2, b, g), kv4(p, 3, b, g), blkmask,
            [&](int) -> bool { return true; },
            [&](int j, int& lo_, int& hi_) { const int l0 = t - 511 - 64 * j, h0 = t - 64 * j; lo_ = l0 > 0 ? l0 : 0; hi_ = h0 < 63 ? h0 : 63; }, tid, lane);
  const float lt = a.l + __shfl_xor(a.l, 32);
  {
    char* wl = smem + wid * 8704;
    cols_to_lds(a, __builtin_amdgcn_rcpf(lt), wl, lane);
    u16* owb = (u16*)(p.ws + OFF_R3) + ((size_t)b * S_ + t0) * 2048 + hd * 128;
    const int srow = lane >> 4, sch = lane & 15;
#pragma unroll
    for (int i = 0; i < 8; ++i) {
      const int row = srow + 4 * i;
      const uint4 v = lds_row_chunk(wl, row, sch);
      *reinterpret_cast<uint4*>(owb + (size_t)row * 2048 + sch * 8) = v;
    }
  }
  __syncthreads();
}

DI void slc_block(const Params& p, int it, int tid, int wid, int lane) {
  const u16* proj = (const u16*)(p.ws + OFF_PROJ);
  const float* psum = (const float*)(p.ws + OFF_PSUM);
  const int rr_ = it >> 8, ii = it & 255, qi = ii >> 3, bg = ii & 7;
  const int q = rr_ == 0 ? 127 - qi : (rr_ == 1 ? 64 + qi : (rr_ == 2 ? 63 - qi : qi));
  const int b = bg >> 1, g = bg & 1, t0 = 32 * q, blk_t = t0 >> 6;
  const int u = lane & 31, h = lane >> 5, tl = u >> 3, r = u & 7;
  const size_t tokbase = (size_t)b * S_;
  unsigned long long msel[4];
#pragma unroll
  for (int k = 0; k < 4; ++k) {
    const size_t tk = tokbase + t0 + 4 * wid + k;
    const float* psrow = psum + (tk * 2 + g) * 256;
    const bool valid = lane <= blk_t;
    if (blk_t < 16) { msel[k] = __ballot(valid); continue; }
    unsigned key;
    {
      const int j = lane;
      const float4 pq = *reinterpret_cast<const float4*>(psrow + 4 * j);
      const float sm = (j > 0 ? psrow[4 * j - 1] : 0.f) + pq.x + pq.y + pq.z + pq.w;
      const bool forced = (j == 0) || (j == blk_t) || (j == blk_t - 1);
      key = valid ? __float_as_uint(sm + (forced ? 1e4f : 0.f)) : 0u;
    }
    unsigned thr = 0u;
    for (int bit = 30; bit >= 0; --bit) {
      const unsigned cand = thr | (1u << bit);
      if (__popcll(__ballot(valid && key >= cand)) >= 16) thr = cand;
    }
    const unsigned long long gt = __ballot(valid && key > thr), eq = __ballot(valid && key == thr);
    const int need = 16 - __popcll(gt);
    const int idx_eq = (int)__builtin_amdgcn_mbcnt_hi((unsigned)(eq >> 32), __builtin_amdgcn_mbcnt_lo((unsigned)eq, 0u));
    msel[k] = __ballot(valid && (key > thr || (key == thr && idx_eq < need)));
  }
  const unsigned long long mysel = tl == 0 ? msel[0] : (tl == 1 ? msel[1] : (tl == 2 ? msel[2] : msel[3]));
  const unsigned long long wunion = msel[0] | msel[1] | msel[2] | msel[3];
  unsigned long long* lu = reinterpret_cast<unsigned long long*>(smem + LDS_UNION);
  { int w2 = wid; asm volatile("" : "+v"(w2)); if (lane == 0) lu[w2] = wunion; }
  __syncthreads();
  const unsigned long long bunion = lu[0] | lu[1] | lu[2] | lu[3] | lu[4] | lu[5] | lu[6] | lu[7];
  const int t = t0 + 4 * wid + tl, hd = 8 * g + r;
  const size_t tok = tokbase + t;
  bf16x8 qf[8];
  {
    const u16* qp = proj + tok * PS + C_QB + hd * 128 + 8 * h;
#pragma unroll
    for (int s = 0; s < 8; ++s) qf[s] = ldg8(qp + 16 * s);
  }
  AttnAcc a; attn_init(a);
  coop_attn(a, qf, kv4(p, 0, b, g), kv4(p, 1, b, g), bunion,
            [&](int j) -> bool { return ((wunion >> j) & 1ull) != 0; },
            [&](int j, int& lo_, int& hi_) { const bool sel = ((mysel >> j) & 1ull) != 0; const int h0 = t - 64 * j; lo_ = sel ? 0 : 1000; hi_ = sel ? (h0 < 63 ? h0 : 63) : -1000; }, tid, lane);
  const float lt = a.l + __shfl_xor(a.l, 32);
  {
    const float inv = __builtin_amdgcn_rcpf(lt);
    const u16* gp = proj + tok * PS + C_GN + hd * 3;
    const float g0 = sigmoidf_(bf2f(gp[0])), g1 = sigmoidf_(bf2f(gp[1])) * inv, g2 = sigmoidf_(bf2f(gp[2]));
    char* wl = smem + wid * 8704;
    {
      int l2 = lane; asm volatile("" : "+v"(l2));
      const uint2* of = reinterpret_cast<const uint2*>(p.ws + OFF_R2) + ((((size_t)(b * 2 + g) * 128 + q) * 8 + wid) * 16) * 64 + l2;
#pragma unroll
      for (int c = 0; c < 4; ++c)
#pragma unroll
        for (int g4 = 0; g4 < 4; ++g4) {
          const uint2 w = of[(c * 4 + g4) * 64];
          a.o[c][4 * g4 + 0] = a.o[c][4 * g4 + 0] * g1 + g0 * bflo(w.x);
          a.o[c][4 * g4 + 1] = a.o[c][4 * g4 + 1] * g1 + g0 * bfhi(w.x);
          a.o[c][4 * g4 + 2] = a.o[c][4 * g4 + 2] * g1 + g0 * bflo(w.y);
          a.o[c][4 * g4 + 3] = a.o[c][4 * g4 + 3] * g1 + g0 * bfhi(w.y);
        }
    }
    cols_to_lds(a, 1.f, wl, lane);
    if (h == 0) reinterpret_cast<float2*>(wl + 8192)[u] = make_float2(0.f, g2);
    int l3 = lane; asm volatile("" : "+v"(l3));
    const int srow = l3 >> 4, sch = l3 & 15;
#pragma unroll
    for (int i = 0; i < 8; ++i) {
      const int row = srow + 4 * i;
      const uint4 v = lds_row_chunk(wl, row, sch);
      const float2 gg = reinterpret_cast<const float2*>(wl + 8192)[row];
      const size_t ro = (tokbase + t0 + 4 * wid + (row >> 3)) * 2048 + (size_t)(8 * g + (row & 7)) * 128 + sch * 8;
      const uint4 ww = *reinterpret_cast<const uint4*>((const u16*)(p.ws + OFF_R3) + ro);
      uint4 y;
      y.x = pk2(bflo(v.x) + gg.y * bflo(ww.x), bfhi(v.x) + gg.y * bfhi(ww.x));
      y.y = pk2(bflo(v.y) + gg.y * bflo(ww.y), bfhi(v.y) + gg.y * bfhi(ww.y));
      y.z = pk2(bflo(v.z) + gg.y * bflo(ww.z), bfhi(v.z) + gg.y * bfhi(ww.z));
      y.w = pk2(bflo(v.w) + gg.y * bflo(ww.w), bfhi(v.w) + gg.y * bfhi(ww.w));
      *reinterpret_cast<uint4*>((u16*)(p.ws + OFF_YB) + ro) = y;
    }
  }
  __syncthreads();
}

DI void dil_merge(const Params& p, int gw, int nw, int lane) {
  const u16* og = (const u16*)(p.ws + OFF_OG);
  const float* lse = (const float*)(p.ws + OFF_LSE);
  u16* ya = (u16*)(p.ws + OFF_YA);
  const int hh = lane >> 4, d0 = (lane & 15) * 8;
  for (int tok = gw; tok < T_; tok += nw) {
    const float l0 = lse[((size_t)0 * T_ + tok) * 4 + hh], l1 = lse[((size_t)1 * T_ + tok) * 4 + hh], l2 = lse[((size_t)2 * T_ + tok) * 4 + hh];
    const float mx = fmaxf(l0, fmaxf(l1, l2));
    float w0 = __expf(l0 - mx), w1 = __expf(l1 - mx), w2 = __expf(l2 - mx);
    const float inv = 1.f / (w0 + w1 + w2);
    w0 *= inv; w1 *= inv; w2 *= inv;
    const uint4 a0 = *reinterpret_cast<const uint4*>(og + ((size_t)0 * T_ + tok) * 512 + hh * 128 + d0);
    const uint4 a1 = *reinterpret_cast<const uint4*>(og + ((size_t)1 * T_ + tok) * 512 + hh * 128 + d0);
    const uint4 a2 = *reinterpret_cast<const uint4*>(og + ((size_t)2 * T_ + tok) * 512 + hh * 128 + d0);
    uint4 o;
    o.x = pk2(w0 * bflo(a0.x) + w1 * bflo(a1.x) + w2 * bflo(a2.x), w0 * bfhi(a0.x) + w1 * bfhi(a1.x) + w2 * bfhi(a2.x));
    o.y = pk2(w0 * bflo(a0.y) + w1 * bflo(a1.y) + w2 * bflo(a2.y), w0 * bfhi(a0.y) + w1 * bfhi(a1.y) + w2 * bfhi(a2.y));
    o.z = pk2(w0 * bflo(a0.z) + w1 * bflo(a1.z) + w2 * bflo(a2.z), w0 * bfhi(a0.z) + w1 * bfhi(a1.z) + w2 * bfhi(a2.z));
    o.w = pk2(w0 * bflo(a0.w) + w1 * bflo(a1.w) + w2 * bflo(a2.w), w0 * bfhi(a0.w) + w1 * bfhi(a1.w) + w2 * bfhi(a2.w));
    *reinterpret_cast<uint4*>(ya + (size_t)tok * 512 + hh * 128 + d0) = o;
  }
}

DI float gelu_tanh(float x) {
  const float y = 0.7978845608028654f * (x + 0.044715f * x * x * x);
  return 0.5f * x * (1.f + tanhf(y));
}
constexpr int GSTR = 528;
DI void cmp_mlp_block(const Params& p, int layer, int item, int wid, int lane) {
  const u16* proj = (const u16*)(p.ws + OFF_PROJ);
  const int kv = item >> 6, rt = item & 63;
  const int g = rt >> 5, b = (rt >> 3) & 3, c0 = (rt & 7) * 32;
  const int u = lane & 31, h = lane >> 5;
  const u16* w1t = (const u16*)(p.ws + (kv ? OFF_W1V_T : OFF_W1K_T));
  const u16* w2t = (const u16*)(p.ws + (kv ? OFF_W2V_T : OFF_W2K_T));
  const float* pos = (kv ? p.cpv : p.cpk) + (size_t)layer * 32 * 128;
  const int ccol = (kv ? C_VC : C_KC) + g * 128;
  f32x16 hacc = zero16();
  {
    const int tokb = b * S_ + 16 * c0;
    for (int idx = wid * 64 + lane; idx < 528 * 16; idx += NTHREADS) {
      const int r = idx >> 4, ch = idx & 15;
      int tk = tokb + r; tk = tk > T_ - 1 ? T_ - 1 : tk;
      const bf16x8 v = ldg8(proj + (size_t)tk * PS + ccol + ch * 8);
      *reinterpret_cast<bf16x8*>(smem + ((r & 15) * 33 + (r >> 4)) * 272 + ch * 16) = v;
    }
  }
  __syncthreads();
  const u16* wfr = w1t + (size_t)wid * 256 * 64 * 8 + lane * 8;
#pragma unroll 2
  for (int l = 0; l < 32; ++l) {
    bf16x8 wf[8];
#pragma unroll
    for (int s2 = 0; s2 < 8; ++s2) wf[s2] = ldg8(wfr + (size_t)(l * 8 + s2) * 64 * 8);
    const char* drow = smem + ((l & 15) * 33 + (l >> 4) + u) * 272 + 16 * h;
    const float* prow = pos + l * 128 + 8 * h;
#pragma unroll
    for (int s2 = 0; s2 < 8; ++s2) {
      const uint4 dv = *reinterpret_cast<const uint4*>(drow + 32 * s2);
      const float4 p0 = *reinterpret_cast<const float4*>(prow + 16 * s2), p1 = *reinterpret_cast<const float4*>(prow + 16 * s2 + 4);
      typedef __attribute__((ext_vector_type(4))) unsigned u32x4;
      u32x4 w;
      w[0] = pk2(bflo(dv.x) + p0.x, bfhi(dv.x) + p0.y);
      w[1] = pk2(bflo(dv.y) + p0.z, bfhi(dv.y) + p0.w);
      w[2] = pk2(bflo(dv.z) + p1.x, bfhi(dv.z) + p1.y);
      w[3] = pk2(bflo(dv.w) + p1.z, bfhi(dv.w) + p1.w);
      const bf16x8 df = __builtin_bit_cast(bf16x8, w);
      hacc = MFMA32(wf[s2], df, hacc);
    }
  }
  __syncthreads();
  char* gl = smem;
#pragma unroll
  for (int g4 = 0; g4 < 4; ++g4) {
    uint2 w;
    w.x = pk2(gelu_tanh(hacc[4 * g4 + 0]), gelu_tanh(hacc[4 * g4 + 1]));
    w.y = pk2(gelu_tanh(hacc[4 * g4 + 2]), gelu_tanh(hacc[4 * g4 + 3]));
    *reinterpret_cast<uint2*>(gl + u * GSTR + (32 * wid + 8 * g4 + 4 * h) * 2) = w;
  }
  __syncthreads();
  if (wid < 2) {
    f32x16 o0 = zero16(), o1 = zero16();
#pragma unroll
    for (int ks = 0; ks < 16; ++ks) {
      const bf16x8 gf = *reinterpret_cast<const bf16x8*>(gl + u * GSTR + (16 * ks + 8 * h) * 2);
      const bf16x8 wa = ldg8(w2t + (size_t)(32 * wid + u) * 256 + 16 * ks + 8 * h);
      const bf16x8 wb = ldg8(w2t + (size_t)(32 * (wid + 2) + u) * 256 + 16 * ks + 8 * h);
      o0 = MFMA32(wa, gf, o0);
      o1 = MFMA32(wb, gf, o1);
    }
    const int cidx = c0 + u;
    if (kv == 0) {
      int tk = b * S_ + 16 * cidx + 31; tk = tk > T_ - 1 ? T_ - 1 : tk;
      const float2* cs = (const float2*)(p.ws + OFF_CS) + (size_t)tk * 64;
#pragma unroll
      for (int i = 0; i < 16; ++i) {
        const float2 cc = cs[32 * wid + crow(i, h)];
        const float x1 = o0[i], x2 = o1[i];
        o0[i] = x1 * cc.x - x2 * cc.y;
        o1[i] = x2 * cc.x + x1 * cc.y;
      }
    }
    u16* dst = (u16*)(p.ws + (kv ? OFF_VCMP : OFF_KCMP)) + ((size_t)(b * 256 + cidx) * 2 + g) * 128;
#pragma unroll
    for (int g4 = 0; g4 < 4; ++g4) {
      uint2 w;
      w.x = pk2(o0[4 * g4 + 0], o0[4 * g4 + 1]); w.y = pk2(o0[4 * g4 + 2], o0[4 * g4 + 3]);
      *reinterpret_cast<uint2*>(dst + 32 * wid + 8 * g4 + 4 * h) = w;
      w.x = pk2(o1[4 * g4 + 0], o1[4 * g4 + 1]); w.y = pk2(o1[4 * g4 + 2], o1[4 * g4 + 3]);
      *reinterpret_cast<uint2*>(dst + 32 * (wid + 2) + 8 * g4 + 4 * h) = w;
    }
  }
  __syncthreads();
}

constexpr int PH_PER_LAYER = 10;
constexpr int N_PHASES = 2 * PH_PER_LAYER + 1;

DI void run_phase(const Params& p, int ph, int tid, int rep, const int bid, const int nb) {
  const int lane = tid & 63, wid = tid >> 6;
  const int gw = bid * 8 + wid, nw = nb * 8;
  char* vlds = smem + wid * (32 * 272 + VTILE_B);
  if (ph == 2 * PH_PER_LAYER) { rmsnorm_f32_inplace(p.out, p.ln_final, gw, nw, lane); return; }
  const int layer = ph / PH_PER_LAYER, sub = ph % PH_PER_LAYER;
  const float* xin = layer == 0 ? p.x : p.out;
  switch (sub) {
    case 0: {
      {
        const float* w = p.w_in + (size_t)layer * 2048 * NIN;
        auto src = [=](int np) -> const float* { const int cp = np & 127; const int n = (np & ~127) + ((cp >> 5) * 16 + (cp & 15)) + 64 * ((cp >> 4) & 1);
          return n < 8192 ? w + n : (n < 12288 ? w + n + 48 : (n < 12336 ? w + n - 4096 : nullptr)); };
        tconv((u16*)(p.ws + OFF_WIN_T), 2048, NINP, NIN, src, bid, nb, tid);
      }
      { const float* w = p.woa + (size_t)layer * 512 * 2048; auto src = [=](int n) -> const float* { return w + n; };
        tconv((u16*)(p.ws + OFF_WOA_T), 512, 2048, 2048, src, bid, nb, tid); }
      { const float* w = p.wob + (size_t)layer * 2048 * 2048; auto src = [=](int n) -> const float* { return w + n; };
        tconv((u16*)(p.ws + OFF_WOB_T), 2048, 2048, 2048, src, bid, nb, tid); }
      { const float* w = p.wo + (size_t)layer * 2048 * 2048; auto src = [=](int n) -> const float* { return w + n; };
        tconv((u16*)(p.ws + OFF_WO_T), 2048, 2048, 2048, src, bid, nb, tid); }
      conv_w1frag((u16*)(p.ws + OFF_W1K_T), p.w1k + (size_t)layer * 4096 * 256, bid * NTHREADS + tid, nb * NTHREADS);
      conv_w1frag((u16*)(p.ws + OFF_W1V_T), p.w1v + (size_t)layer * 4096 * 256, bid * NTHREADS + tid, nb * NTHREADS);
      { const float* w = p.w2k + (size_t)layer * 256 * 128; auto src = [=](int n) -> const float* { return w + n; };
        tconv((u16*)(p.ws + OFF_W2K_T), 256, 128, 128, src, bid, nb, tid); }
      { const float* w = p.w2v + (size_t)layer * 256 * 128; auto src = [=](int n) -> const float* { return w + n; };
        tconv((u16*)(p.ws + OFF_W2V_T), 256, 128, 128, src, bid, nb, tid); }
      if (layer == 0) {
        float2* cs = (float2*)(p.ws + OFF_CS);
        const float inv = powf(10000.0f, -2.0f * (float)lane / 128.0f);
        for (int tok = gw; tok < T_; tok += nw) {
          const float ang = (float)p.pos[tok] * inv;
          float sn, cn; sincosf(ang, &sn, &cn);
          cs[(size_t)tok * 64 + lane] = make_float2(cn, sn);
        }
      }
      rmsnorm_bf16(xin, p.ln_mix + (size_t)layer * 2048, (u16*)(p.ws + OFF_R2), gw, nw, lane);
    } break;
    case 1: gemm_proj(p, bid, nb, tid); break;
    case 2: {
      for (int it = bid; it < 128; it += nb) cmp_mlp_block(p, layer, it, wid, lane);
      if (nb == 256) {
        const int lowc = bid < 128;
        const int vw = ((bid & 7) * 16 + ((lowc ? bid : bid - 128) >> 3)) * 8 + wid;
        const int dcnt = lowc ? 2 : 4, dbase = lowc ? vw * 2 : 2048 + vw * 4;
        for (int k = 0; k < dcnt; ++k) dil_item(p, dbase + k, vlds, lane);
      } else {
        for (int it = gw; it < 6144; it += nw) dil_item(p, it, vlds, lane);
      }
    } break;
    case 3: {
      for (int it = bid; it < 1024; it += nb) win_block(p, it, tid, wid, lane);
      for (int sit = bid; sit < 256; sit += nb) cmp_block(p, sit, tid, wid, lane);
    } break;
    case 4: {
      for (int it = bid; it < 1024; it += nb) slc_block(p, it, tid, wid, lane);
      dil_merge(p, gw, nw, lane);
    } break;
    case 5: gemm_merge(p, bid, nb, tid); break;
    case 6: gemm_resid((const u16*)(p.ws + OFF_R3), (const u16*)(p.ws + OFF_WO_T), 2048, xin, rep ? (float*)(p.ws + OFF_PROJ) : p.out, bid, nb, tid); break;
    case 7: {
      {
        const float* wgp = p.wg + (size_t)layer * 2048 * DFF; const float* wup = p.wu + (size_t)layer * 2048 * DFF;
        auto src = [=](int n) -> const float* { const int pt = n >> 8, r = n & 255; return r < 128 ? wgp + pt * 128 + r : wup + pt * 128 + (r - 128); };
        tconv((u16*)(p.ws + OFF_WGU_T), 2048, 11264, DFF, src, bid, nb, tid);
      }
      { const float* w = p.wd + (size_t)layer * DFF * 2048; auto src = [=](int n) -> const float* { return w + n; };
        tconv((u16*)(p.ws + OFF_WD_T), DFF, 2048, 2048, src, bid, nb, tid); }
      rmsnorm_bf16(p.out, p.ln_ffn + (size_t)layer * 2048, (u16*)(p.ws + OFF_R2), gw, nw, lane);
    } break;
    case 8: gemm_gateup(p, bid, nb, tid); break;
    case 9: gemm_resid((const u16*)(p.ws + OFF_PROJ), (const u16*)(p.ws + OFF_WD_T), DFF, p.out, rep ? (float*)(p.ws + OFF_R2) : p.out, bid, nb, tid); break;
  }
}

DI unsigned bar_ld(unsigned* p) { return __hip_atomic_load(p, __ATOMIC_RELAXED, __HIP_MEMORY_SCOPE_AGENT); }
DI unsigned bar_add(unsigned* p) { return __hip_atomic_fetch_add(p, 1u, __ATOMIC_RELAXED, __HIP_MEMORY_SCOPE_AGENT); }
DI void fast_grid_sync(unsigned* bar, const unsigned k, const unsigned nb, const unsigned bid, int tid) {
  asm volatile("s_waitcnt vmcnt(0) lgkmcnt(0)" ::: "memory");
  __syncthreads();
  if (tid == 0) {
    __builtin_amdgcn_fence(__ATOMIC_RELEASE, "agent");
    asm volatile("s_waitcnt vmcnt(0)" ::: "memory");
    const unsigned g = bid & 7u, gsz = nb >> 3;
    unsigned spins = 0;
    const unsigned old = bar_add(bar + 64 * g);
    bool last = false;
    if (old + 1u == k * gsz) last = (bar_add(bar + 64 * 16) + 1u == k * 8u);
    if (!last) while (bar_ld(bar + 64 * 16) < k * 8u && ++spins < (1u << 22)) __builtin_amdgcn_s_sleep(1);
    __builtin_amdgcn_fence(__ATOMIC_ACQUIRE, "agent");
    asm volatile("s_waitcnt vmcnt(0)" ::: "memory");
  }
  __syncthreads();
}

__global__ void __launch_bounds__(NTHREADS) fwd_kernel(Params p, int ph0, int ph1) {
  if (ph1 < 0) cg::this_grid().sync();
  const int widx = __builtin_amdgcn_readfirstlane((int)(threadIdx.x >> 6));
  unsigned nbar = 0;
  for (int pi = ph0; pi < ph1; ++pi) {
    int ph = pi, rep = 0;
    if (N_PROBE > 0 && pi >= N_PHASES) { ph = (pi == N_PHASES) ? PROBE_A : PROBE_B; rep = 1; }
    int tid;
    asm volatile("v_mbcnt_lo_u32_b32 %0, -1, 0\n\tv_mbcnt_hi_u32_b32 %0, -1, %0\n\tv_lshl_add_u32 %0, %1, 6, %0" : "=&v"(tid) : "s"(widx));
    int bid_ = blockIdx.x, nb_ = gridDim.x;
    asm volatile("" : "+s"(bid_), "+s"(nb_));
    run_phase(p, ph, tid, rep, bid_, nb_);
    if (pi + 1 < ph1) {
      ++nbar; fast_grid_sync(reinterpret_cast<unsigned*>(p.ws + OFF_BAR), nbar, gridDim.x, blockIdx.x, tid);
    }
  }
}

extern "C" void kernel_launch(void* const* d_in, const int* in_sizes, int n_in, void* d_out, int out_size, void* d_ws,
                              size_t ws_size, hipStream_t stream) {
  if (n_in != 18 || ws_size < WS_END) { fprintf(stderr, "kernel_launch: unexpected n_in %d or ws_size %zu < %zu\n", n_in, ws_size, (size_t)WS_END); return; }
  Params p{};
  p.x = (const float*)d_in[0]; p.pos = (const int*)d_in[1]; p.ln_mix = (const float*)d_in[2]; p.w_in = (const float*)d_in[3];
  p.cpk = (const float*)d_in[4]; p.cpv = (const float*)d_in[5]; p.w1k = (const float*)d_in[6]; p.w2k = (const float*)d_in[7];
  p.w1v = (const float*)d_in[8]; p.w2v = (const float*)d_in[9]; p.woa = (const float*)d_in[10]; p.wob = (const float*)d_in[11];
  p.wo = (const float*)d_in[12]; p.ln_ffn = (const float*)d_in[13]; p.wg = (const float*)d_in[14]; p.wu = (const float*)d_in[15];
  p.wd = (const float*)d_in[16]; p.ln_final = (const float*)d_in[17];
  p.out = (float*)d_out; p.ws = (char*)d_ws;
  static int grid_blocks = 0;
  if (!grid_blocks) {
    int dev = 0, cus = 0, per_cu = 0;
    hipGetDevice(&dev);
    hipDeviceGetAttribute(&cus, hipDeviceAttributeMultiprocessorCount, dev);
    hipOccupancyMaxActiveBlocksPerMultiprocessor(&per_cu, fwd_kernel, NTHREADS, 0);
    if (per_cu < 1) per_cu = 1;
    if (per_cu > 1) per_cu = 1;
    grid_blocks = cus * per_cu;
    if (grid_blocks % 8) grid_blocks -= grid_blocks % 8;
  }
#if MULTI_LAUNCH
  for (int ph = 0; ph < N_PHASES; ++ph) {
    hipLaunchKernelGGL(fwd_kernel, dim3(grid_blocks), dim3(NTHREADS), 0, stream, p, ph, ph + 1);
  }
#else
  int ph0 = 0, ph1 = N_PHASES + N_PROBE;
  (void)hipMemsetAsync((char*)d_ws + OFF_BAR, 0, 8192, stream);
  void* args[] = {&p, &ph0, &ph1};
  hipError_t e = hipLaunchCooperativeKernel((void*)fwd_kernel, dim3(grid_blocks), dim3(NTHREADS), args, 0, stream);
  if (e != hipSuccess) fprintf(stderr, "cooperative launch failed: %s (grid %d)\n", hipGetErrorString(e), grid_blocks);
#endif
}
```

```cpp
#include <hip/hip_runtime.h>
#include <hip/hip_cooperative_groups.h>
#include <cstdio>
#include <cstdint>
namespace cg = cooperative_groups;

#define PROBE_A -1
#define PROBE_B -1
#define N_PROBE ((PROBE_A >= 0 ? 1 : 0) + (PROBE_B >= 0 ? 1 : 0))
#ifndef MULTI_LAUNCH
#define MULTI_LAUNCH 0
#endif

typedef unsigned short u16;
typedef __attribute__((ext_vector_type(8))) short bf16x8;
typedef __attribute__((ext_vector_type(4))) short s16x4;
typedef __attribute__((ext_vector_type(4))) float f32x4;
typedef __attribute__((ext_vector_type(16))) float f32x16;
typedef __attribute__((ext_vector_type(2))) float f32x2_t;
typedef __attribute__((ext_vector_type(2))) __bf16 bf16x2_t;

#define DI __device__ __forceinline__
#define MFMA32(a, b, c) __builtin_amdgcn_mfma_f32_32x32x16_bf16((a), (b), (c), 0, 0, 0)

constexpr int T_ = 16384, S_ = 4096, NB_ = 4, D_ = 2048, NIN = 12336, PS = 12352, NINP = 12544, DFF = 5632;
constexpr int C_QA = 0, C_KA = 1536, C_VA = 3072, C_QB = 4608, C_KC = 6656, C_VC = 6912, C_KS = 7168, C_VS = 7424,
              C_KW = 7680, C_VW = 7936, C_GA = 8192, C_GB = 10240, C_GN = 12288;
constexpr float SCALE = 0.08838834764831845f;
constexpr float NEG = -1e30f;
constexpr int NTHREADS = 512;
constexpr int VSTRIDE = 288;
constexpr int VTILE_B = 32 * VSTRIDE;

constexpr size_t OFF_WIN_T = 0;
constexpr size_t OFF_PSUM = OFF_WIN_T;
constexpr size_t OFF_YA = OFF_WIN_T + 33554432;
constexpr size_t OFF_WOA_T = OFF_WIN_T + (size_t)NINP * 2048 * 2;
constexpr size_t OFF_WOB_T = OFF_WOA_T + (size_t)2048 * 512 * 2;
constexpr size_t OFF_WO_T = OFF_WOB_T + (size_t)2048 * 2048 * 2;
constexpr size_t OFF_W1K_T = OFF_WO_T + (size_t)2048 * 2048 * 2;
constexpr size_t OFF_W1V_T = OFF_W1K_T + (size_t)256 * 4096 * 2;
constexpr size_t OFF_W2K_T = OFF_W1V_T + (size_t)256 * 4096 * 2;
constexpr size_t OFF_W2V_T = OFF_W2K_T + (size_t)128 * 256 * 2;
constexpr size_t OFF_PROJ = OFF_W2V_T + (size_t)128 * 256 * 2;
constexpr size_t OFF_R2 = OFF_PROJ + (size_t)T_ * PS * 2;
constexpr size_t OFF_R3 = OFF_R2 + (size_t)T_ * 2048 * 2;
constexpr size_t OFF_YB = OFF_R3 + (size_t)T_ * 2048 * 2;
constexpr size_t OFF_OG = OFF_YB + (size_t)T_ * 2048 * 2;
constexpr size_t OFF_LSE = OFF_OG + (size_t)3 * T_ * 512 * 2;
constexpr size_t OFF_WGU_T = OFF_YB;
constexpr size_t OFF_WD_T = OFF_WGU_T + (size_t)11264 * 2048 * 2;
constexpr size_t OFF_CS = OFF_LSE + (size_t)3 * T_ * 4 * 4;
constexpr size_t OFF_KCMP = OFF_CS + (size_t)T_ * 64 * 8;
constexpr size_t OFF_VCMP = OFF_KCMP + (size_t)4 * 256 * 2 * 128 * 2;
constexpr size_t OFF_KV4 = OFF_VCMP + (size_t)4 * 256 * 2 * 128 * 2;
constexpr size_t OFF_BAR = OFF_KV4 + (size_t)4 * T_ * 2 * 128 * 2;
constexpr size_t WS_END = OFF_BAR + 8192;
static_assert(OFF_WD_T + (size_t)2048 * 5632 * 2 <= OFF_CS, "ffn weight alias overflow");
static_assert(OFF_YA + (size_t)T_ * 512 * 2 <= OFF_WOA_T, "ya alias overflow");

struct Params {
  const float* x; const int* pos; const float* ln_mix; const float* w_in; const float* cpk; const float* cpv;
  const float* w1k; const float* w2k; const float* w1v; const float* w2v; const float* woa; const float* wob;
  const float* wo; const float* ln_ffn; const float* wg; const float* wu; const float* wd; const float* ln_final;
  float* out; char* ws;
};

__shared__ __attribute__((aligned(16))) char smem[147456];

DI unsigned pk2(float a, float b) {
  f32x2_t v = {a, b};
  bf16x2_t r = __builtin_convertvector(v, bf16x2_t);
  return __builtin_bit_cast(unsigned, r);
}
DI float bf2f(u16 b) { return __uint_as_float(((unsigned)b) << 16); }
DI float bflo(unsigned w) { return __uint_as_float(w << 16); }
DI float bfhi(unsigned w) { return __uint_as_float(w & 0xffff0000u); }
DI u16 f2bf(float a) { return (u16)(pk2(a, 0.f) & 0xffffu); }
DI bf16x8 ldg8(const u16* p) { return *reinterpret_cast<const bf16x8*>(p); }
DI float wave_sum(float v) {
#pragma unroll
  for (int o = 32; o >= 1; o >>= 1) v += __shfl_xor(v, o);
  return v;
}
DI float sigmoidf_(float v) { return 1.f / (1.f + __expf(-v)); }
DI int crow(int i, int h) { return (i & 3) + 8 * (i >> 2) + 4 * h; }
DI f32x16 zero16() { f32x16 z;
#pragma unroll
  for (int i = 0; i < 16; ++i) z[i] = 0.f; return z; }
DI bf16x8 pack8(const f32x16& x, int s) {
  unsigned w0 = pk2(x[8 * s + 0], x[8 * s + 1]), w1 = pk2(x[8 * s + 2], x[8 * s + 3]);
  unsigned w2 = pk2(x[8 * s + 4], x[8 * s + 5]), w3 = pk2(x[8 * s + 6], x[8 * s + 7]);
  typedef __attribute__((ext_vector_type(4))) unsigned u32x4;
  u32x4 p = {w0, w1, w2, w3};
  return __builtin_bit_cast(bf16x8, p);
}

template <class SRC>
DI void tconv(u16* __restrict__ dst, int K, int Npad, int ldsrc, SRC src, int bid, int nb, int tid) {
  float* tile = (float*)smem;
  const int nk = K / 128, nn = Npad / 128, ntile = nk * nn;
  float4 v[8];
  auto load_tile = [&](int t) {
    const int kt = t % nk, nt = t / nk, k0 = kt * 128, n0 = nt * 128;
#pragma unroll
    for (int e = 0; e < 8; ++e) {
      const int idx = tid + 512 * e, kk = idx >> 5, n4 = (idx & 31) * 4;
      const float* cp = src(n0 + n4);
      v[e] = cp ? *reinterpret_cast<const float4*>(cp + (size_t)(k0 + kk) * ldsrc) : make_float4(0.f, 0.f, 0.f, 0.f);
    }
  };
  if (bid < ntile) load_tile(bid);
  for (int t = bid; t < ntile; t += nb) {
    const int kt = t % nk, nt = t / nk, k0 = kt * 128, n0 = nt * 128;
#pragma unroll
    for (int e = 0; e < 8; ++e) {
      const int idx = tid + 512 * e, kk = idx >> 5, n4 = (idx & 31) * 4;
      float* tp = tile + kk * 129 + n4;
      tp[0] = v[e].x; tp[1] = v[e].y; tp[2] = v[e].z; tp[3] = v[e].w;
    }
    if (t + nb < ntile) load_tile(t + nb);
    __syncthreads();
#pragma unroll
    for (int e = 0; e < 4; ++e) {
      const int c = tid + 512 * e;
      const int nl = (c & 7) + 8 * (c >> 7), kc = ((c >> 3) & 15) * 8;
      const float* tp = tile + kc * 129 + nl;
      uint4 w;
      w.x = pk2(tp[0 * 129], tp[1 * 129]);
      w.y = pk2(tp[2 * 129], tp[3 * 129]);
      w.z = pk2(tp[4 * 129], tp[5 * 129]);
      w.w = pk2(tp[6 * 129], tp[7 * 129]);
      *reinterpret_cast<uint4*>(dst + (size_t)(n0 + nl) * K + k0 + kc) = w;
    }
    __syncthreads();
  }
}

DI void conv_w1frag(u16* __restrict__ dst, const float* __restrict__ w1, int gtid, int nthr) {
  for (int it = gtid; it < 8 * 256 * 64; it += nthr) {
    const int ln = it & 63, ks = (it >> 6) & 255, nbk = it >> 14;
    const float* sp = w1 + (size_t)(16 * ks + 8 * (ln >> 5)) * 256 + 32 * nbk + (ln & 31);
    uint4 w;
    w.x = pk2(sp[0 * 256], sp[1 * 256]); w.y = pk2(sp[2 * 256], sp[3 * 256]);
    w.z = pk2(sp[4 * 256], sp[5 * 256]); w.w = pk2(sp[6 * 256], sp[7 * 256]);
    *reinterpret_cast<uint4*>(dst + (size_t)it * 8) = w;
  }
}

DI void rmsnorm_bf16(const float* __restrict__ x, const float* __restrict__ g, u16* __restrict__ h, int gw, int nw, int lane) {
  for (int row = gw; row < T_; row += nw) {
    const float4* xr = reinterpret_cast<const float4*>(x + (size_t)row * D_);
    float4 v[8];
    float ss = 0.f;
#pragma unroll
    for (int i = 0; i < 8; ++i) { v[i] = xr[lane + 64 * i]; ss += v[i].x * v[i].x + v[i].y * v[i].y + v[i].z * v[i].z + v[i].w * v[i].w; }
    ss = wave_sum(ss);
    const float rs = rsqrtf(ss * (1.f / 2048.f) + 1e-6f);
    uint2* hr = reinterpret_cast<uint2*>(h + (size_t)row * D_);
#pragma unroll
    for (int i = 0; i < 8; ++i) {
      const float4 gg = reinterpret_cast<const float4*>(g)[lane + 64 * i];
      uint2 o;
      o.x = pk2(v[i].x * rs * gg.x, v[i].y * rs * gg.y);
      o.y = pk2(v[i].z * rs * gg.z, v[i].w * rs * gg.w);
      hr[lane + 64 * i] = o;
    }
  }
}
DI void rmsnorm_f32_inplace(float* __restrict__ x, const float* __restrict__ g, int gw, int nw, int lane) {
  for (int row = gw; row < T_; row += nw) {
    float4* xr = reinterpret_cast<float4*>(x + (size_t)row * D_);
    float4 v[8];
    float ss = 0.f;
#pragma unroll
    for (int i = 0; i < 8; ++i) { v[i] = xr[lane + 64 * i]; ss += v[i].x * v[i].x + v[i].y * v[i].y + v[i].z * v[i].z + v[i].w * v[i].w; }
    ss = wave_sum(ss);
    const float rs = rsqrtf(ss * (1.f / 2048.f) + 1e-6f);
#pragma unroll
    for (int i = 0; i < 8; ++i) {
      const float4 gg = reinterpret_cast<const float4*>(g)[lane + 64 * i];
      float4 o;
      o.x = v[i].x * rs * gg.x; o.y = v[i].y * rs * gg.y; o.z = v[i].z * rs * gg.z; o.w = v[i].w * rs * gg.w;
      xr[lane + 64 * i] = o;
    }
  }
}

constexpr int BM = 256, BK = 64, HALF = 128, NXCD = 8, WGM = 8, HT = HALF * BK;

DI int lds_byte(int r, int c) {
  int st = (r >> 4) * 2 + (c >> 5), rr = r & 15, cc = c & 31, ob = rr * 64 + cc * 2;
  return st * 1024 + (ob ^ (((ob >> 9) & 1) << 5));
}
DI void stage_rc(int b, int& R, int& C) {
  int st = b / 1024, sb = b % 1024, swz = sb ^ (((sb >> 9) & 1) << 5);
  R = (st >> 1) * 16 + swz / 64; C = (st & 1) * 32 + (swz % 64) / 2;
}

typedef f32x4 GemmAcc[2][2][4][2];

DI void gemm_kloop(const u16* __restrict__ A, const u16* __restrict__ Bt, const int K, const int brow, const int bcol, GemmAcc& acc, const int tid) {
  u16* shm = reinterpret_cast<u16*>(smem);
#define SA(b, h) (shm + ((b) * 2 + (h)) * HT)
#define SB(b, h) (shm + (4 + (b) * 2 + (h)) * HT)
#define STAGE(P, BASE, br, kt) do { const unsigned _ub = (unsigned)(((br) * K + (kt) * BK) * 2); \
    __builtin_amdgcn_global_load_lds((const unsigned*)((const char*)(BASE) + (size_t)(_ub + so0)), \
        (unsigned*)((char*)(P) + tid * 16), 16, 0, 0); \
    __builtin_amdgcn_global_load_lds((const unsigned*)((const char*)(BASE) + (size_t)(_ub + so1)), \
        (unsigned*)((char*)(P) + tid * 16 + 8192), 16, 0, 0); } while (0)
#define LDA(dst, b, h) for (int m = 0; m < 4; ++m) for (int k = 0; k < 2; ++k) \
    dst[m][k] = *reinterpret_cast<const bf16x8*>((char*)SA(b, h) + aoff + m * 2048 + k * 1024)
#define LDB(dst, b, h) for (int n = 0; n < 2; ++n) for (int k = 0; k < 2; ++k) \
    dst[n][k] = *reinterpret_cast<const bf16x8*>((char*)SB(b, h) + boff + n * 2048 + k * 1024)
#define MMA(ai, bj, At, Bt_) do { __builtin_amdgcn_s_setprio(1); \
    for (int m = 0; m < 4; ++m) for (int n = 0; n < 2; ++n) for (int k = 0; k < 2; ++k) \
      acc[ai][bj][m][n] = __builtin_amdgcn_mfma_f32_16x16x32_bf16(Bt_[n][k], At[m][k], acc[ai][bj][m][n], 0, 0, 0); \
    __builtin_amdgcn_s_setprio(0); } while (0)
#define WAIT_V(n) asm volatile("s_waitcnt vmcnt(" #n ")" ::: "memory")
#define WAIT_L(n) asm volatile("s_waitcnt lgkmcnt(" #n ")" ::: "memory")
#define BAR __builtin_amdgcn_s_barrier()
#define SCHED __builtin_amdgcn_sched_barrier(0)
  const int wid = tid >> 6, lane = tid & 63, wr = wid >> 2, wc = wid & 3, fr = lane & 15, fq = lane >> 4;
  bf16x8 At[4][2], B0[2][2], B1[2][2];
  unsigned so0, so1;
  { int r0, c0; stage_rc(tid * 16, r0, c0); so0 = (unsigned)((r0 * K + c0) * 2); so1 = so0 + (unsigned)(64 * K * 2); }
  const int lanepart = lds_byte(fr, fq * 8);
  const int aoff = wr * 8192 + lanepart, boff = wc * 4096 + lanepart;
  const int nt = K / BK;
  STAGE(SB(0, 0), Bt, bcol, 0); STAGE(SA(0, 0), A, brow, 0);
  STAGE(SB(0, 1), Bt, bcol + HALF, 0); STAGE(SA(0, 1), A, brow + HALF, 0);
  if (wr == 1) BAR;
  WAIT_V(4); BAR;
  STAGE(SB(1, 0), Bt, bcol, 1); STAGE(SA(1, 0), A, brow, 1); STAGE(SB(1, 1), Bt, bcol + HALF, 1);
  WAIT_V(6); BAR;
  for (int t = 0; t < nt - 2; t += 2) {
    LDB(B0, 0, 0); SCHED; LDA(At, 0, 0); STAGE(SA(1, 1), A, brow + HALF, t + 1);
    WAIT_L(8); BAR; WAIT_L(0); MMA(0, 0, At, B0); BAR; SCHED;
    LDB(B1, 0, 1); STAGE(SB(0, 0), Bt, bcol, t + 2);
    BAR; WAIT_L(0); MMA(0, 1, At, B1); BAR;
    LDA(At, 0, 1); STAGE(SA(0, 0), A, brow, t + 2);
    BAR; WAIT_L(0); MMA(1, 0, At, B0); BAR; SCHED;
    STAGE(SB(0, 1), Bt, bcol + HALF, t + 2);
    WAIT_V(6); BAR; MMA(1, 1, At, B1); BAR;
    LDB(B0, 1, 0); SCHED; LDA(At, 1, 0); STAGE(SA(0, 1), A, brow + HALF, t + 2);
    WAIT_L(8); BAR; WAIT_L(0); MMA(0, 0, At, B0); BAR; SCHED;
    LDB(B1, 1, 1); STAGE(SB(1, 0), Bt, bcol, t + 3);
    BAR; WAIT_L(0); MMA(0, 1, At, B1); BAR;
    LDA(At, 1, 1); STAGE(SA(1, 0), A, brow, t + 3);
    BAR; WAIT_L(0); MMA(1, 0, At, B0); BAR; SCHED;
    STAGE(SB(1, 1), Bt, bcol + HALF, t + 3);
    WAIT_V(6); BAR; MMA(1, 1, At, B1); BAR;
  }
  { LDB(B0, 0, 0); LDA(At, 0, 0); STAGE(SA(1, 1), A, brow + HALF, nt - 1);
    BAR; WAIT_L(0); MMA(0, 0, At, B0); BAR;
    LDB(B1, 0, 1); BAR; WAIT_L(0); MMA(0, 1, At, B1); BAR;
    LDA(At, 0, 1); WAIT_V(4); BAR; WAIT_L(0); MMA(1, 0, At, B0); MMA(1, 1, At, B1); BAR; }
  { LDB(B0, 1, 0); LDA(At, 1, 0); WAIT_V(2); BAR; WAIT_L(0); MMA(0, 0, At, B0); BAR;
    LDB(B1, 1, 1); WAIT_V(0); BAR; WAIT_L(0); MMA(0, 1, At, B1); BAR;
    LDA(At, 1, 1); BAR; WAIT_L(0); MMA(1, 0, At, B0); MMA(1, 1, At, B1); BAR; }
  if (wr == 0) BAR;
}

#define PAIR(BR1, BC1, T1, BR2, BC2, T2, T3) \
    LDB(B0, 0, 0); SCHED; LDA(At, 0, 0); STAGE(SA(1, 1), A, (BR1) + HALF, T1); \
    WAIT_L(8); BAR; WAIT_L(0); MMA(0, 0, At, B0); BAR; SCHED; \
    LDB(B1, 0, 1); STAGE(SB(0, 0), Bt, BC2, T2); \
    BAR; WAIT_L(0); MMA(0, 1, At, B1); BAR; \
    LDA(At, 0, 1); STAGE(SA(0, 0), A, BR2, T2); \
    BAR; WAIT_L(0); MMA(1, 0, At, B0); BAR; SCHED; \
    STAGE(SB(0, 1), Bt, (BC2) + HALF, T2); \
    WAIT_V(6); BAR; MMA(1, 1, At, B1); BAR; \
    LDB(B0, 1, 0); SCHED; LDA(At, 1, 0); STAGE(SA(0, 1), A, (BR2) + HALF, T2); \
    WAIT_L(8); BAR; WAIT_L(0); MMA(0, 0, At, B0); BAR; SCHED; \
    LDB(B1, 1, 1); STAGE(SB(1, 0), Bt, BC2, T3); \
    BAR; WAIT_L(0); MMA(0, 1, At, B1); BAR; \
    LDA(At, 1, 1); STAGE(SA(1, 0), A, BR2, T3); \
    BAR; WAIT_L(0); MMA(1, 0, At, B0); BAR; SCHED; \
    STAGE(SB(1, 1), Bt, (BC2) + HALF, T3); \
    WAIT_V(6); BAR; MMA(1, 1, At, B1); BAR;

__device__ __forceinline__ void gemm_tile_coords(int id, int nM, int nN, int& pm, int& pn);

template <class EPI>
DI void gemm_stream(const u16* __restrict__ A, const u16* __restrict__ Bt, const int K, const int nM, const int nN,
                    const int bid, const int nb, const int tid, EPI epi) {
  const int ntot = nM * nN;
  if (bid >= ntot) return;
  u16* shm = reinterpret_cast<u16*>(smem);
  const int wid = tid >> 6, lane = tid & 63, wr = wid >> 2, wc = wid & 3, fr = lane & 15, fq = lane >> 4;
  unsigned so0, so1;
  { int r0, c0; stage_rc(tid * 16, r0, c0); so0 = (unsigned)((r0 * K + c0) * 2); so1 = so0 + (unsigned)(64 * K * 2); }
  const int lanepart = lds_byte(fr, fq * 8);
  const int aoff = wr * 8192 + lanepart, boff = wc * 4096 + lanepart;
  const int nt = K / BK;
  int pm, pn; gemm_tile_coords(bid, nM, nN, pm, pn);
  int brow = pm * BM, bcol = pn * BM;
  GemmAcc acc = {};
  STAGE(SB(0, 0), Bt, bcol, 0); STAGE(SA(0, 0), A, brow, 0);
  STAGE(SB(0, 1), Bt, bcol + HALF, 0); STAGE(SA(0, 1), A, brow + HALF, 0);
  if (wr == 1) BAR;
  WAIT_V(4); BAR;
  STAGE(SB(1, 0), Bt, bcol, 1); STAGE(SA(1, 0), A, brow, 1); STAGE(SB(1, 1), Bt, bcol + HALF, 1);
  WAIT_V(6); BAR;
  for (int id = bid; id < ntot; id += nb) {
    const int idn = id + nb;
    int pm2 = pm, pn2 = pn;
    if (idn < ntot) gemm_tile_coords(idn, nM, nN, pm2, pn2);
    const int brow2 = pm2 * BM, bcol2 = pn2 * BM;
    for (int t = 0; t < nt; t += 2) {
      const bool inside = (t + 2 < nt);
      const int brs = inside ? brow : brow2, bcs = inside ? bcol : bcol2, t2 = inside ? t + 2 : 0;
      bf16x8 At[4][2], B0[2][2], B1[2][2];
      PAIR(brow, bcol, t + 1, brs, bcs, t2, t2 + 1)
    }
    epi(acc, brow, bcol, pn);
#pragma unroll
    for (int ai = 0; ai < 2; ++ai)
#pragma unroll
      for (int bj = 0; bj < 2; ++bj)
#pragma unroll
        for (int m = 0; m < 4; ++m)
#pragma unroll
          for (int n = 0; n < 2; ++n) acc[ai][bj][m][n] = (f32x4){0.f, 0.f, 0.f, 0.f};
    brow = brow2; bcol = bcol2; pm = pm2; pn = pn2;
  }
  WAIT_V(0);
  if (wr == 0) BAR;
  BAR;
}

DI void gemm_tile_coords(int id, int nM, int nN, int& pm, int& pn) {
  const int nwg = nM * nN;
  int q = nwg / NXCD, r = nwg % NXCD, xcd = id % NXCD, off = id / NXCD;
  int wgid = (xcd < r ? xcd * (q + 1) : r * (q + 1) + (xcd - r) * q) + off;
  int nig = WGM * nN, gid = wgid / nig, fm = gid * WGM, gsz = min(nM - fm, WGM);
  pm = fm + ((wgid % nig) % gsz); pn = (wgid % nig) / gsz;
}

#define ACC_FOREACH _Pragma("unroll") for (int ai = 0; ai < 2; ++ai) _Pragma("unroll") for (int bj = 0; bj < 2; ++bj) _Pragma("unroll") for (int m = 0; m < 4; ++m) _Pragma("unroll") for (int n = 0; n < 2; ++n)
#define ACC_ROW (brow + ai * HALF + wr * 64 + m * 16 + fr)
#define ACC_COL (bcol + bj * HALF + wc * 32 + n * 16 + fq * 4)
#define GEMM_IDS int tid_ = tid; asm volatile("" : "+v"(tid_)); const int wid = tid_ >> 6, lane = tid_ & 63, wr = wid >> 2, wc = wid & 3, fr = lane & 15, fq = lane >> 4; (void)lane;
#define EPI_SCHED __builtin_amdgcn_sched_barrier(0)

DI void gemm_proj(const Params& p, int bid, int nb, int tid) {
  const u16* A = (const u16*)(p.ws + OFF_R2);
  const u16* Bt = (const u16*)(p.ws + OFF_WIN_T);
  u16* C = (u16*)(p.ws + OFF_PROJ);
  const int nM = T_ / BM, nN = NINP / BM;
  gemm_stream(A, Bt, 2048, nM, nN, bid, nb, tid, [&](GemmAcc& acc, const int brow, const int bcol, const int pn) {
    GEMM_IDS
    const bool rope_tile = (pn < 12) || (pn >= 18 && pn < 26) || pn == 28 || pn == 30;
    const bool kv_tile = (pn >= 28 && pn < 32);
    const int d1 = wc * 16 + fq * 4;
    const float* cs = (const float*)(p.ws + OFF_CS);
#pragma unroll
    for (int ai = 0; ai < 2; ++ai) {
      float4 c01[4], c23[4];
#pragma unroll
      for (int m = 0; m < 4; ++m) {
        const int row = brow + ai * HALF + wr * 64 + m * 16 + fr;
        c01[m] = make_float4(1.f, 0.f, 1.f, 0.f); c23[m] = c01[m];
        if (rope_tile) {
          c01[m] = *reinterpret_cast<const float4*>(cs + ((size_t)row * 64 + d1) * 2);
          c23[m] = *reinterpret_cast<const float4*>(cs + ((size_t)row * 64 + d1) * 2 + 4);
        }
      }
#pragma unroll
      for (int m = 0; m < 4; ++m) {
        const int row = brow + ai * HALF + wr * 64 + m * 16 + fr;
#pragma unroll
        for (int bj = 0; bj < 2; ++bj) {
          const f32x4 x1 = acc[ai][bj][m][0], x2 = acc[ai][bj][m][1];
          uint2 w1, w2;
          w1.x = pk2(x1[0] * c01[m].x - x2[0] * c01[m].y, x1[1] * c01[m].z - x2[1] * c01[m].w);
          w1.y = pk2(x1[2] * c23[m].x - x2[2] * c23[m].y, x1[3] * c23[m].z - x2[3] * c23[m].w);
          w2.x = pk2(x2[0] * c01[m].x + x1[0] * c01[m].y, x2[1] * c01[m].z + x1[1] * c01[m].w);
          w2.y = pk2(x2[2] * c23[m].x + x1[2] * c23[m].y, x2[3] * c23[m].z + x1[3] * c23[m].w);
          const int col1 = bcol + bj * HALF + d1;
          if (kv_tile) {
            u16* dk = (u16*)(p.ws + OFF_KV4) + ((size_t)((((pn - 28) * 4 + (row >> 12)) * 2 + bj) * 4096 + (row & 4095))) * 128 + d1;
            *reinterpret_cast<uint2*>(dk) = w1;
            *reinterpret_cast<uint2*>(dk + 64) = w2;
          } else {
            if (col1 < PS) *reinterpret_cast<uint2*>(C + (size_t)row * PS + col1) = w1;
            if (col1 + 64 < PS) *reinterpret_cast<uint2*>(C + (size_t)row * PS + col1 + 64) = w2;
          }
        }
      }
      EPI_SCHED;
    }
  });
}

DI void gemm_merge(const Params& p, int bid, int nb, int tid) {
  const u16* A1 = (const u16*)(p.ws + OFF_YA);
  const u16* B1 = (const u16*)(p.ws + OFF_WOA_T);
  const u16* A2 = (const u16*)(p.ws + OFF_YB);
  const u16* B2 = (const u16*)(p.ws + OFF_WOB_T);
  const u16* proj = (const u16*)(p.ws + OFF_PROJ);
  u16* C = (u16*)(p.ws + OFF_R3);
  const int nM = T_ / BM, nN = 2048 / BM;
  for (int id = bid; id < nM * nN; id += nb) {
    int pm, pn; gemm_tile_coords(id, nM, nN, pm, pn);
    const int brow = pm * BM, bcol = pn * BM;
    GemmAcc acc = {};
    gemm_kloop(A1, B1, 512, brow, bcol, acc, tid);
    {
    GEMM_IDS
#pragma unroll
    for (int ai = 0; ai < 2; ++ai)
#pragma unroll
      for (int bj = 0; bj < 2; ++bj) {
        uint2 gw[4][2];
#pragma unroll
        for (int m = 0; m < 4; ++m)
#pragma unroll
          for (int n = 0; n < 2; ++n) gw[m][n] = *reinterpret_cast<const uint2*>(proj + (size_t)ACC_ROW * PS + C_GA + ACC_COL);
#pragma unroll
        for (int m = 0; m < 4; ++m)
#pragma unroll
          for (int n = 0; n < 2; ++n) {
            f32x4& v = acc[ai][bj][m][n];
            uint2 w;
            w.x = pk2(v[0] * sigmoidf_(bflo(gw[m][n].x)), v[1] * sigmoidf_(bfhi(gw[m][n].x)));
            w.y = pk2(v[2] * sigmoidf_(bflo(gw[m][n].y)), v[3] * sigmoidf_(bfhi(gw[m][n].y)));
            *reinterpret_cast<uint2*>(C + (size_t)ACC_ROW * 2048 + ACC_COL) = w;
            v[0] = 0.f; v[1] = 0.f; v[2] = 0.f; v[3] = 0.f;
          }
        EPI_SCHED;
      }
    }
    gemm_kloop(A2, B2, 2048, brow, bcol, acc, tid);
    GEMM_IDS
#pragma unroll
    for (int ai = 0; ai < 2; ++ai)
#pragma unroll
      for (int bj = 0; bj < 2; ++bj) {
        uint2 gw[4][2], old[4][2];
#pragma unroll
        for (int m = 0; m < 4; ++m)
#pragma unroll
          for (int n = 0; n < 2; ++n) {
            gw[m][n] = *reinterpret_cast<const uint2*>(proj + (size_t)ACC_ROW * PS + C_GB + ACC_COL);
            old[m][n] = *reinterpret_cast<const uint2*>(C + (size_t)ACC_ROW * 2048 + ACC_COL);
          }
#pragma unroll
        for (int m = 0; m < 4; ++m)
#pragma unroll
          for (int n = 0; n < 2; ++n) {
            const f32x4 v = acc[ai][bj][m][n];
            uint2 w;
            w.x = pk2(bflo(old[m][n].x) + v[0] * sigmoidf_(bflo(gw[m][n].x)), bfhi(old[m][n].x) + v[1] * sigmoidf_(bfhi(gw[m][n].x)));
            w.y = pk2(bflo(old[m][n].y) + v[2] * sigmoidf_(bflo(gw[m][n].y)), bfhi(old[m][n].y) + v[3] * sigmoidf_(bfhi(gw[m][n].y)));
            *reinterpret_cast<uint2*>(C + (size_t)ACC_ROW * 2048 + ACC_COL) = w;
          }
        EPI_SCHED;
      }
  }
}

DI void gemm_resid(const u16* A, const u16* Bt, int K, const float* xin, float* xout, int bid, int nb, int tid) {
  const int nM = T_ / BM, nN = 2048 / BM;
  gemm_stream(A, Bt, K, nM, nN, bid, nb, tid, [&](GemmAcc& acc, const int brow, const int bcol, const int pn) {
    (void)pn;
    GEMM_IDS
#pragma unroll
    for (int ai = 0; ai < 2; ++ai)
#pragma unroll
      for (int bj = 0; bj < 2; ++bj) {
        float4 xi[4][2];
#pragma unroll
        for (int m = 0; m < 4; ++m)
#pragma unroll
          for (int n = 0; n < 2; ++n) xi[m][n] = *reinterpret_cast<const float4*>(xin + (size_t)ACC_ROW * 2048 + ACC_COL);
#pragma unroll
        for (int m = 0; m < 4; ++m)
#pragma unroll
          for (int n = 0; n < 2; ++n) {
            const f32x4 v = acc[ai][bj][m][n];
            float4 r; r.x = xi[m][n].x + v[0]; r.y = xi[m][n].y + v[1]; r.z = xi[m][n].z + v[2]; r.w = xi[m][n].w + v[3];
            *reinterpret_cast<float4*>(xout + (size_t)ACC_ROW * 2048 + ACC_COL) = r;
          }
        EPI_SCHED;
      }
  });
}

DI void gemm_gateup(const Params& p, int bid, int nb, int tid) {
  const u16* A = (const u16*)(p.ws + OFF_R2);
  const u16* Bt = (const u16*)(p.ws + OFF_WGU_T);
  u16* C = (u16*)(p.ws + OFF_PROJ);
  const int nM = T_ / BM, nN = 11264 / BM;
  gemm_stream(A, Bt, 2048, nM, nN, bid, nb, tid, [&](GemmAcc& acc, const int brow, const int bcol, const int pn) {
    (void)bcol;
    GEMM_IDS
    _Pragma("unroll") for (int ai = 0; ai < 2; ++ai) _Pragma("unroll") for (int m = 0; m < 4; ++m) _Pragma("unroll") for (int n = 0; n < 2; ++n) {
      const int col = pn * 128 + wc * 32 + n * 16 + fq * 4;
      const int row = brow + ai * HALF + wr * 64 + m * 16 + fr;
      const f32x4 g = acc[ai][0][m][n], uu = acc[ai][1][m][n];
      uint2 w;
      w.x = pk2(g[0] * sigmoidf_(g[0]) * uu[0], g[1] * sigmoidf_(g[1]) * uu[1]);
      w.y = pk2(g[2] * sigmoidf_(g[2]) * uu[2], g[3] * sigmoidf_(g[3]) * uu[3]);
      *reinterpret_cast<uint2*>(C + (size_t)row * DFF + col) = w;
      EPI_SCHED;
    }
  });
}

struct AttnAcc { f32x16 o[4]; float m, l; };
DI void attn_init(AttnAcc& a) {
#pragma unroll
  for (int c = 0; c < 4; ++c) a.o[c] = zero16();
  a.m = NEG; a.l = 0.f;
}
DI f32x16 qk_tile(const bf16x8 (&qf)[8], const u16* kp) {
  bf16x8 kf[8];
#pragma unroll
  for (int s = 0; s < 8; ++s) kf[s] = ldg8(kp + 16 * s);
  f32x16 st = zero16();
#pragma unroll
  for (int s = 0; s < 8; ++s) st = MFMA32(kf[s], qf[s], st);
  return st;
}
template <int B>
DI void tr_read8(unsigned addr, s16x4 (&r)[8]) {
  asm volatile("ds_read_b64_tr_b16 %0, %8 offset:%9\n\tds_read_b64_tr_b16 %1, %8 offset:%10\n\t"
               "ds_read_b64_tr_b16 %2, %8 offset:%11\n\tds_read_b64_tr_b16 %3, %8 offset:%12\n\t"
               "ds_read_b64_tr_b16 %4, %8 offset:%13\n\tds_read_b64_tr_b16 %5, %8 offset:%14\n\t"
               "ds_read_b64_tr_b16 %6, %8 offset:%15\n\tds_read_b64_tr_b16 %7, %8 offset:%16\n\ts_waitcnt lgkmcnt(0)"
               : "=&v"(r[0]), "=&v"(r[1]), "=&v"(r[2]), "=&v"(r[3]), "=&v"(r[4]), "=&v"(r[5]), "=&v"(r[6]), "=&v"(r[7])
               : "v"(addr), "i"(B), "i"(8 * VSTRIDE + B), "i"(16 * VSTRIDE + B), "i"(24 * VSTRIDE + B),
                 "i"(B + 64), "i"(8 * VSTRIDE + B + 64), "i"(16 * VSTRIDE + B + 64), "i"(24 * VSTRIDE + B + 64)
               : "memory");
}
template <int C>
DI void pv_block2(f32x16& oa, f32x16& ob, unsigned vbase, const bf16x8& pf0, const bf16x8& pf1) {
  s16x4 r[8];
  tr_read8<64 * C>(vbase, r);
  const bf16x8 a0 = __builtin_shufflevector(r[0], r[1], 0, 1, 2, 3, 4, 5, 6, 7);
  const bf16x8 a1 = __builtin_shufflevector(r[2], r[3], 0, 1, 2, 3, 4, 5, 6, 7);
  const bf16x8 b0 = __builtin_shufflevector(r[4], r[5], 0, 1, 2, 3, 4, 5, 6, 7);
  const bf16x8 b1 = __builtin_shufflevector(r[6], r[7], 0, 1, 2, 3, 4, 5, 6, 7);
  oa = MFMA32(a0, pf0, oa);
  ob = MFMA32(b0, pf0, ob);
  oa = MFMA32(a1, pf1, oa);
  ob = MFMA32(b1, pf1, ob);
}
template <class VR>
DI void v_stage(VR vrow, char* vlds, int lane) {
  bf16x8 vst[8];
#pragma unroll
  for (int i = 0; i < 8; ++i) { const int nn = lane + 64 * i; vst[i] = ldg8(vrow(nn >> 4) + 8 * (nn & 15)); }
#pragma unroll
  for (int i = 0; i < 8; ++i) { const int nn = lane + 64 * i; *reinterpret_cast<bf16x8*>(vlds + VSTRIDE * (nn >> 4) + 16 * (nn & 15)) = vst[i]; }
}
DI unsigned v_base(char* vlds, int lane) {
  const int h = lane >> 5, blk = (lane >> 4) & 1, q = (lane & 15) >> 2, pp = lane & 3;
  return (unsigned)(size_t)vlds + VSTRIDE * (4 * h + q) + 32 * blk + 8 * pp;
}
DI void pv_tile(AttnAcc& a, const f32x16& pr, char* vlds, int lane) {
  const bf16x8 pf0 = pack8(pr, 0), pf1 = pack8(pr, 1);
  const unsigned vb = v_base(vlds, lane);
  asm volatile("s_waitcnt lgkmcnt(0)" ::: "memory");
  pv_block2<0>(a.o[0], a.o[1], vb, pf0, pf1);
  pv_block2<2>(a.o[2], a.o[3], vb, pf0, pf1);
}
template <class VR, class MK>
DI void attn_tile(AttnAcc& a, const bf16x8 (&qf)[8], const u16* kp, VR vrow, MK mask, char* vlds, int lane) {
  const int h = lane >> 5;
  f32x16 st = qk_tile(qf, kp);
  v_stage(vrow, vlds, lane);
  float mx = a.m;
#pragma unroll
  for (int i = 0; i < 16; ++i) {
    const float sv = mask(crow(i, h)) ? st[i] * SCALE : NEG;
    st[i] = sv; mx = fmaxf(mx, sv);
  }
  mx = fmaxf(mx, __shfl_xor(mx, 32));
  const float alpha = __expf(a.m - mx);
  a.m = mx;
  float ls = 0.f;
#pragma unroll
  for (int i = 0; i < 16; ++i) { const float pv = (st[i] > -1e29f) ? __expf(st[i] - mx) : 0.f; st[i] = pv; ls += pv; }
  a.l = a.l * alpha + ls;
#pragma unroll
  for (int c = 0; c < 4; ++c) a.o[c] *= alpha;
  pv_tile(a, st, vlds, lane);
}
DI void store_col(const AttnAcc& a, float sc, u16* dst, int h) {
#pragma unroll
  for (int c = 0; c < 4; ++c)
#pragma unroll
    for (int g4 = 0; g4 < 4; ++g4) {
      uint2 w;
      w.x = pk2(a.o[c][4 * g4 + 0] * sc, a.o[c][4 * g4 + 1] * sc);
      w.y = pk2(a.o[c][4 * g4 + 2] * sc, a.o[c][4 * g4 + 3] * sc);
      *reinterpret_cast<uint2*>(dst + 32 * c + 8 * g4 + 4 * h) = w;
    }
}

DI f32x16 qk_tile_lds(const bf16x8 (&qf)[8], const char* kr);
DI void cols_to_lds(const AttnAcc& a, float sc, char* tl, int lane) {
  asm volatile("" : "+v"(lane));
  const int u = lane & 31, h = lane >> 5;
#pragma unroll
  for (int c = 0; c < 4; ++c)
#pragma unroll
    for (int g4 = 0; g4 < 4; ++g4) {
      uint2 w;
      w.x = pk2(a.o[c][4 * g4 + 0] * sc, a.o[c][4 * g4 + 1] * sc);
      w.y = pk2(a.o[c][4 * g4 + 2] * sc, a.o[c][4 * g4 + 3] * sc);
      *reinterpret_cast<uint2*>(tl + u * 256 + (((4 * c + g4) ^ (u & 15)) << 4) + 8 * h) = w;
    }
  asm volatile("s_waitcnt lgkmcnt(0)" ::: "memory");
}
DI uint4 lds_row_chunk(const char* tl, int row, int chunk) {
  asm volatile("" : "+v"(row), "+v"(chunk));
  return *reinterpret_cast<const uint4*>(tl + row * 256 + ((chunk ^ (row & 15)) << 4));
}

DI void tile_compute32(AttnAcc& a, const bf16x8 (&qf)[8], const char* Kl, char* Vl, const int lo, const int hi, int lane) {
  const int u = lane & 31, h = lane >> 5;
  f32x16 st = qk_tile_lds(qf, Kl + u * 272 + 16 * h);
  constexpr float C2 = SCALE * 1.4426950408889634f;
  const bool empty = lo > hi;
  const unsigned span = empty ? 0u : (unsigned)(hi - lo);
  const int lo3 = empty ? (1 << 20) : lo - 4 * h;
  float mx = a.m;
#pragma unroll
  for (int i = 0; i < 16; ++i) {
    const int vc = (i & 3) + 8 * (i >> 2);
    const bool ok = (unsigned)(vc - lo3) <= span;
    const float sv = ok ? st[i] * C2 : NEG;
    st[i] = sv; mx = fmaxf(mx, sv);
  }
  mx = fmaxf(mx, __shfl_xor(mx, 32));
  const float msafe = (mx == NEG) ? 0.f : mx;
  const float alpha = __builtin_amdgcn_exp2f(a.m - msafe);
  a.m = mx;
  float ls = 0.f;
#pragma unroll
  for (int i = 0; i < 16; ++i) { const float pv = __builtin_amdgcn_exp2f(st[i] - msafe); st[i] = pv; ls += pv; }
  a.l = a.l * alpha + ls;
#pragma unroll
  for (int c = 0; c < 4; ++c) a.o[c] *= alpha;
  pv_tile(a, st, Vl, lane);
}

DI void dil_item(const Params& p, int item, char* wlds, int lane) {
  const u16* proj = (const u16*)(p.ws + OFF_PROJ);
  const int b = item / 1536, rem = item % 1536, head = rem >> 7, ti = rem & 127;
  const int gi = head >> 2, hh = head & 3;
  const int r = (gi == 0) ? 1 : (gi == 1 ? 4 : 16);
  const int tpc = (S_ / r) / 32;
  const int cres = ti / tpc, i0 = (ti % tpc) * 32;
  const int u = lane & 31, h = lane >> 5;
  const size_t tokbase = (size_t)b * S_;
  const int tq = r * (i0 + u) + cres;
  char* Kl = wlds;
  char* Vl = wlds + 32 * 272;
  bf16x8 qf[8];
  {
    const u16* qp = proj + (tokbase + tq) * PS + C_QA + head * 128 + 8 * h;
#pragma unroll
    for (int s = 0; s < 8; ++s) qf[s] = ldg8(qp + 16 * s);
  }
  const int srow = lane >> 4, sch = lane & 15;
  const int kt0 = (i0 >= 128) ? 0 : (128 - i0) >> 5;
  bf16x8 kst[8], vst[8];
  auto load_tile = [&](int kt) {
    const int kb = i0 - 128 + 32 * kt;
#pragma unroll
    for (int i = 0; i < 8; ++i) {
      int ii = kb + srow + 4 * i; ii = ii < 0 ? 0 : ii;
      const u16* rp = proj + (tokbase + (size_t)(r * ii + cres)) * PS + head * 128 + sch * 8;
      kst[i] = ldg8(rp + C_KA);
      vst[i] = ldg8(rp + C_VA);
    }
  };
  load_tile(kt0);
  AttnAcc a; attn_init(a);
  for (int kt = kt0; kt < 5; ++kt) {
#pragma unroll
    for (int i = 0; i < 8; ++i) {
      *reinterpret_cast<bf16x8*>(Kl + (srow + 4 * i) * 272 + sch * 16) = kst[i];
      *reinterpret_cast<bf16x8*>(Vl + (srow + 4 * i) * VSTRIDE + sch * 16) = vst[i];
    }
    if (kt + 1 < 5) load_tile(kt + 1);
    const int kb = i0 - 128 + 32 * kt;
    const int qi = i0 + u;
    int lo_ = qi - 128 - kb; if (lo_ < -kb) lo_ = -kb; if (lo_ < 0) lo_ = 0;
    int hi_ = qi - kb; if (hi_ > 31) hi_ = 31;
    tile_compute32(a, qf, Kl, Vl, lo_, hi_, lane);
  }
  const float lt = a.l + __shfl_xor(a.l, 32);
  cols_to_lds(a, 1.f / lt, Kl, lane);
  {
    u16* ogb = (u16*)(p.ws + OFF_OG) + ((size_t)gi * T_ + tokbase) * 512 + hh * 128;
#pragma unroll
    for (int i = 0; i < 8; ++i) {
      const int row = srow + 4 * i;
      const uint4 v = lds_row_chunk(Kl, row, sch);
      *reinterpret_cast<uint4*>(ogb + (size_t)(r * (i0 + row) + cres) * 512 + sch * 8) = v;
    }
  }
  if (h == 0) ((float*)(p.ws + OFF_LSE))[((size_t)gi * T_ + tokbase + tq) * 4 + hh] = a.m * 0.6931471805599453f + __logf(lt);
}

constexpr int CMP_KL = 256 * 272;
DI f32x16 qk_tile_lds(const bf16x8 (&qf)[8], const char* kr) {
  bf16x8 kf[8];
#pragma unroll
  for (int s = 0; s < 8; ++s) kf[s] = *reinterpret_cast<const bf16x8*>(kr + 32 * s);
  f32x16 st = zero16();
#pragma unroll
  for (int s = 0; s < 8; ++s) st = MFMA32(kf[s], qf[s], st);
  return st;
}
DI void cmp_block(const Params& p, int sit, int tid, int wid, int lane) {
  const u16* proj = (const u16*)(p.ws + OFF_PROJ);
  const u16* kcmp = (const u16*)(p.ws + OFF_KCMP);
  const u16* vcmp = (const u16*)(p.ws + OFF_VCMP);
  float* psum = (float*)(p.ws + OFF_PSUM);
  const int bg = sit & 7, slot = sit >> 3, b = bg >> 1, g = bg & 1;
  char* Kl = smem;
  char* Vl = smem + CMP_KL;
  __syncthreads();
  {
    bf16x8 tmp[8];
#pragma unroll
    for (int e = 0; e < 8; ++e) { const int idx = tid + 512 * e; tmp[e] = ldg8(kcmp + ((size_t)(b * 256 + (idx >> 4)) * 2 + g) * 128 + (idx & 15) * 8); }
#pragma unroll
    for (int e = 0; e < 8; ++e) { const int idx = tid + 512 * e; *reinterpret_cast<bf16x8*>(Kl + (idx >> 4) * 272 + (idx & 15) * 16) = tmp[e]; }
#pragma unroll
    for (int e = 0; e < 8; ++e) { const int idx = tid + 512 * e; tmp[e] = ldg8(vcmp + ((size_t)(b * 256 + (idx >> 4)) * 2 + g) * 128 + (idx & 15) * 8); }
#pragma unroll
    for (int e = 0; e < 8; ++e) { const int idx = tid + 512 * e; *reinterpret_cast<bf16x8*>(Vl + (idx >> 4) * VSTRIDE + (idx & 15) * 16) = tmp[e]; }
  }
  __syncthreads();
  const int u = lane & 31, h = lane >> 5, tl = u >> 3, rr = u & 7;
  const size_t tokbase = (size_t)b * S_;
  for (int qq = 0; qq < 4; ++qq) {
    const int q = qq == 0 ? slot : (qq == 1 ? 63 - slot : (qq == 2 ? 64 + slot : 127 - slot));
    const int t0 = 32 * q + 4 * wid;
    const int tq = t0 + tl, head = g * 8 + rr;
    bf16x8 qf[8];
    {
      const u16* qp = proj + (tokbase + tq) * PS + C_QB + head * 128 + 8 * h;
#pragma unroll
      for (int s = 0; s < 8; ++s) qf[s] = ldg8(qp + 16 * s);
    }
    const int nv = tq >= 31 ? ((tq - 31) >> 4) + 1 : 0;
    const int nvmax = (t0 + 3) >= 31 ? ((t0 + 3 - 31) >> 4) + 1 : 0;
    const int ntile = (nvmax + 31) >> 5;
    float mrun = NEG, lrun = 0.f;
    for (int kt = 0; kt < ntile; ++kt) {
      f32x16 st = qk_tile_lds(qf, Kl + (32 * kt + u) * 272 + 16 * h);
      float mx = mrun;
#pragma unroll
      for (int i = 0; i < 16; ++i) {
        const float sv = (32 * kt + crow(i, h) < nv) ? st[i] * SCALE : NEG;
        st[i] = sv; mx = fmaxf(mx, sv);
      }
      mx = fmaxf(mx, __shfl_xor(mx, 32));
      float ls = 0.f;
#pragma unroll
      for (int i = 0; i < 16; ++i) ls += (st[i] > -1e29f) ? __expf(st[i] - mx) : 0.f;
      lrun = lrun * __expf(mrun - mx) + ls;
      mrun = mx;
    }
    const float lt = lrun + __shfl_xor(lrun, 32);
    const float inv = 1.f / fmaxf(lt, 1e-30f);
    AttnAcc a; attn_init(a);
    float* psrow = psum + ((tokbase + tq) * 2 + g) * 256;
    for (int kt = 0; kt < ntile; ++kt) {
      f32x16 st = qk_tile_lds(qf, Kl + (32 * kt + u) * 272 + 16 * h);
      float psv[16];
#pragma unroll
      for (int i = 0; i < 16; ++i) {
        const bool ok = (32 * kt + crow(i, h) < nv);
        const float pv = ok ? __expf(st[i] * SCALE - mrun) * inv : 0.f;
        st[i] = pv;
        float ps = pv;
        ps += __shfl_xor(ps, 1); ps += __shfl_xor(ps, 2); ps += __shfl_xor(ps, 4);
        psv[i] = ps;
      }
      if (rr == 0) {
#pragma unroll
        for (int g4 = 0; g4 < 4; ++g4)
          *reinterpret_cast<float4*>(psrow + 32 * kt + 8 * g4 + 4 * h) = make_float4(psv[4 * g4], psv[4 * g4 + 1], psv[4 * g4 + 2], psv[4 * g4 + 3]);
      }
      pv_tile(a, st, Vl + 32 * kt * VSTRIDE, lane);
    }
    for (int kt = ntile; kt < 8; ++kt) {
      if (rr == 0) {
#pragma unroll
        for (int g4 = 0; g4 < 4; ++g4) *reinterpret_cast<float4*>(psrow + 32 * kt + 8 * g4 + 4 * h) = make_float4(0.f, 0.f, 0.f, 0.f);
      }
    }
    {
      uint2* of = reinterpret_cast<uint2*>(p.ws + OFF_R2) + ((((size_t)(b * 2 + g) * 128 + q) * 8 + wid) * 16) * 64 + lane;
#pragma unroll
      for (int c = 0; c < 4; ++c)
#pragma unroll
        for (int g4 = 0; g4 < 4; ++g4) {
          uint2 w;
          w.x = pk2(a.o[c][4 * g4 + 0], a.o[c][4 * g4 + 1]);
          w.y = pk2(a.o[c][4 * g4 + 2], a.o[c][4 * g4 + 3]);
          of[(c * 4 + g4) * 64] = w;
        }
    }
  }
  __syncthreads();
}

constexpr int KSTR = 272;
constexpr int STG_K = 64 * KSTR;
constexpr int STG_B = STG_K + 64 * VSTRIDE;
constexpr int LDS_UNION = 2 * STG_B;

DI void coop_compute(AttnAcc& a, const bf16x8 (&qf)[8], char* stg, const int lo, const int hi, int lane) {
  const int u = lane & 31, h = lane >> 5;
  f32x16 st[2];
#pragma unroll
  for (int hf = 0; hf < 2; ++hf) {
    const char* kr = stg + (32 * hf + u) * KSTR + 16 * h;
    bf16x8 kf[8];
#pragma unroll
    for (int s = 0; s < 8; ++s) kf[s] = *reinterpret_cast<const bf16x8*>(kr + 32 * s);
    st[hf] = zero16();
#pragma unroll
    for (int s = 0; s < 8; ++s) st[hf] = MFMA32(kf[s], qf[s], st[hf]);
  }
  constexpr float C2 = SCALE * 1.4426950408889634f;
  const bool full = (lo <= 0) && (hi >= 63), empty = lo > hi;
  float mx = a.m;
  if (__all(full || empty)) {
    const float cs = full ? C2 : 0.f, ad = full ? 0.f : NEG;
#pragma unroll
    for (int hf = 0; hf < 2; ++hf)
#pragma unroll
      for (int i = 0; i < 16; ++i) { const float sv = fmaf(st[hf][i], cs, ad); st[hf][i] = sv; mx = fmaxf(mx, sv); }
  } else {
    const unsigned span = empty ? 0u : (unsigned)(hi - lo);
    const int lo3 = empty ? (1 << 20) : lo - 4 * h;
#pragma unroll
    for (int hf = 0; hf < 2; ++hf)
#pragma unroll
      for (int i = 0; i < 16; ++i) {
        const int vc = 32 * hf + (i & 3) + 8 * (i >> 2);
        const bool ok = (unsigned)(vc - lo3) <= span;
        const float sv = ok ? st[hf][i] * C2 : NEG;
        st[hf][i] = sv; mx = fmaxf(mx, sv);
      }
  }
  mx = fmaxf(mx, __shfl_xor(mx, 32));
  const float msafe = (mx == NEG) ? 0.f : mx;
  const float alpha = __builtin_amdgcn_exp2f(a.m - msafe);
  a.m = mx;
  float ls = 0.f;
#pragma unroll
  for (int hf = 0; hf < 2; ++hf)
#pragma unroll
    for (int i = 0; i < 16; ++i) { const float pv = __builtin_amdgcn_exp2f(st[hf][i] - msafe); st[hf][i] = pv; ls += pv; }
  a.l = a.l * alpha + ls;
  if (!__all(alpha == 1.f)) {
#pragma unroll
    for (int c = 0; c < 4; ++c) a.o[c] *= alpha;
  }
  pv_tile(a, st[0], stg + STG_K, lane);
  pv_tile(a, st[1], stg + STG_K + 32 * VSTRIDE, lane);
}

template <class NEED, class MK>
DI void coop_attn(AttnAcc& a, const bf16x8 (&qf)[8], const u16* __restrict__ Kg, const u16* __restrict__ Vg,
                  unsigned long long blkmask, NEED need, MK mask, int tid, int lane) {
  if (!blkmask) return;
  const int r0 = tid >> 4, ch = tid & 15;
  const int ko = r0 * KSTR + ch * 16, vo = STG_K + r0 * VSTRIDE + ch * 16;
#define CA_POP(dst) do { if (blkmask) { dst = __builtin_ctzll(blkmask); blkmask &= blkmask - 1; } else dst = -1; } while (0)
#define CA_LOAD(S, jj) do { const size_t go_ = (size_t)(64 * (jj) + r0) * 128 + ch * 8; \
    S##0 = ldg8(Kg + go_); S##1 = ldg8(Kg + go_ + 32 * 128); S##2 = ldg8(Vg + go_); S##3 = ldg8(Vg + go_ + 32 * 128); } while (0)
#define CA_STORE(S, st_) do { char* s_ = (st_); *reinterpret_cast<bf16x8*>(s_ + ko) = S##0; *reinterpret_cast<bf16x8*>(s_ + ko + 32 * KSTR) = S##1; \
    *reinterpret_cast<bf16x8*>(s_ + vo) = S##2; *reinterpret_cast<bf16x8*>(s_ + vo + 32 * VSTRIDE) = S##3; } while (0)
#define CA_STEP(LD, ST) { CA_POP(j2); if (j2 >= 0) CA_LOAD(LD, j2); \
    if (need(j)) { int lo_, hi_; mask(j, lo_, hi_); coop_compute(a, qf, smem + cur * STG_B, lo_, hi_, lane); } \
    if (j1 >= 0) CA_STORE(ST, smem + (cur ^ 1) * STG_B); \
    __syncthreads(); \
    if (j1 < 0) break; \
    j = j1; j1 = j2; cur ^= 1; }
  bf16x8 A0, A1, A2, A3, B0, B1, B2, B3;
  int j, j1, j2, cur = 0;
  CA_POP(j); CA_POP(j1);
  CA_LOAD(A, j);
  CA_STORE(A, smem);
  if (j1 >= 0) CA_LOAD(A, j1);
  __syncthreads();
  for (;;) {
    CA_STEP(B, A)
    CA_STEP(A, B)
  }
#undef CA_POP
#undef CA_LOAD
#undef CA_STORE
#undef CA_STEP
}
DI const u16* kv4(const Params& p, int tensor, int b, int g) {
  return (const u16*)(p.ws + OFF_KV4) + (size_t)((tensor * 4 + b) * 2 + g) * 4096 * 128;
}

DI void win_block(const Params& p, int it, int tid, int wid, int lane) {
  const u16* proj = (const u16*)(p.ws + OFF_PROJ);
  const int q = it >> 3, bg = it & 7, b = bg >> 1, g = bg & 1, t0 = 32 * q;
  const int u = lane & 31, h = lane >> 5;
  const int hd = 8 * g + wid, t = t0 + u;
  const size_t tok = (size_t)b * S_ + t;
  bf16x8 qf[8];
  {
    const u16* qp = proj + tok * PS + C_QB + hd * 128 + 8 * h;
#pragma unroll
    for (int s = 0; s < 8; ++s) qf[s] = ldg8(qp + 16 * s);
  }
  const int lo = (t0 - 511 > 0 ? t0 - 511 : 0) >> 6, hi = (t0 + 31) >> 6;
  const unsigned long long blkmask = ((~0ull) >> (63 - hi)) & ((~0ull) << lo);
  AttnAcc a; attn_init(a);
  coop_attn(a, qf, kv4(p, 2, b, g), kv4(p, 3, b, g), blkmask,
            [&](int) -> bool { return true; },
            [&](int j, int& lo_, int& hi_) { const int l0 = t - 511 - 64 * j, h0 = t - 64 * j; lo_ = l0 > 0 ? l0 : 0; hi_ = h0 < 63 ? h0 : 63; }, tid, lane);
  const float lt = a.l + __shfl_xor(a.l, 32);
  {
    char* wl = smem + wid * 8704;
    cols_to_lds(a, __builtin_amdgcn_rcpf(lt), wl, lane);
    u16* owb = (u16*)(p.ws + OFF_R3) + ((size_t)b * S_ + t0) * 2048 + hd * 128;
    const int srow = lane >> 4, sch = lane & 15;
#pragma unroll
    for (int i = 0; i < 8; ++i) {
      const int row = srow + 4 * i;
      const uint4 v = lds_row_chunk(wl, row, sch);
      *reinterpret_cast<uint4*>(owb + (size_t)row * 2048 + sch * 8) = v;
    }
  }
  __syncthreads();
}

DI void slc_block(const Params& p, int it, int tid, int wid, int lane) {
  const u16* proj = (const u16*)(p.ws + OFF_PROJ);
  const float* psum = (const float*)(p.ws + OFF_PSUM);
  const int rr_ = it >> 8, ii = it & 255, qi = ii >> 3, bg = ii & 7;
  const int q = rr_ == 0 ? 127 - qi : (rr_ == 1 ? 64 + qi : (rr_ == 2 ? 63 - qi : qi));
  const int b = bg >> 1, g = bg & 1, t0 = 32 * q, blk_t = t0 >> 6;
  const int u = lane & 31, h = lane >> 5, tl = u >> 3, r = u & 7;
  const size_t tokbase = (size_t)b * S_;
  const int t = t0 + 4 * wid + tl, hd = 8 * g + r;
  const size_t tok = tokbase + t;
  bf16x8 qf[8];
  {
    const u16* qp = proj + tok * PS + C_QB + hd * 128 + 8 * h;
#pragma unroll
    for (int s = 0; s < 8; ++s) qf[s] = ldg8(qp + 16 * s);
  }
  unsigned long long msel[4];
#pragma unroll
  for (int k = 0; k < 4; ++k) {
    const size_t tk = tokbase + t0 + 4 * wid + k;
    const float* psrow = psum + (tk * 2 + g) * 256;
    const bool valid = lane <= blk_t;
    if (blk_t < 16) { msel[k] = __ballot(valid); continue; }
    unsigned key;
    {
      const int j = lane;
      const float4 pq = *reinterpret_cast<const float4*>(psrow + 4 * j);
      const float sm = (j > 0 ? psrow[4 * j - 1] : 0.f) + pq.x + pq.y + pq.z + pq.w;
      const bool forced = (j == 0) || (j == blk_t) || (j == blk_t - 1);
      key = valid ? __float_as_uint(sm + (forced ? 1e4f : 0.f)) : 0u;
    }
    unsigned thr = 0u;
    for (int bit = 30; bit >= 0; --bit) {
      const unsigned cand = thr | (1u << bit);
      if (__popcll(__ballot(valid && key >= cand)) >= 16) thr = cand;
    }
    const unsigned long long gt = __ballot(valid && key > thr), eq = __ballot(valid && key == thr);
    const int need = 16 - __popcll(gt);
    const int idx_eq = (int)__builtin_amdgcn_mbcnt_hi((unsigned)(eq >> 32), __builtin_amdgcn_mbcnt_lo((unsigned)eq, 0u));
    msel[k] = __ballot(valid && (key > thr || (key == thr && idx_eq < need)));
  }
  const unsigned long long mysel = tl == 0 ? msel[0] : (tl == 1 ? msel[1] : (tl == 2 ? msel[2] : msel[3]));
  const unsigned long long wunion = msel[0] | msel[1] | msel[2] | msel[3];
  unsigned long long* lu = reinterpret_cast<unsigned long long*>(smem + LDS_UNION);
  { int w2 = wid; asm volatile("" : "+v"(w2)); if (lane == 0) lu[w2] = wunion; }
  __syncthreads();
  const unsigned long long bunion = lu[0] | lu[1] | lu[2] | lu[3] | lu[4] | lu[5] | lu[6] | lu[7];
  AttnAcc a; attn_init(a);
  coop_attn(a, qf, kv4(p, 0, b, g), kv4(p, 1, b, g), bunion,
            [&](int j) -> bool { return ((wunion >> j) & 1ull) != 0; },
            [&](int j, int& lo_, int& hi_) { const bool sel = ((mysel >> j) & 1ull) != 0; const int h0 = t - 64 * j; lo_ = sel ? 0 : 1000; hi_ = sel ? (h0 < 63 ? h0 : 63) : -1000; }, tid, lane);
  const float lt = a.l + __shfl_xor(a.l, 32);
  {
    const float inv = __builtin_amdgcn_rcpf(lt);
    const u16* gp = proj + tok * PS + C_GN + hd * 3;
    const float g0 = sigmoidf_(bf2f(gp[0])), g1 = sigmoidf_(bf2f(gp[1])) * inv, g2 = sigmoidf_(bf2f(gp[2]));
    char* wl = smem + wid * 8704;
    {
      int l2 = lane; asm volatile("" : "+v"(l2));
      const uint2* of = reinterpret_cast<const uint2*>(p.ws + OFF_R2) + ((((size_t)(b * 2 + g) * 128 + q) * 8 + wid) * 16) * 64 + l2;
#pragma unroll
      for (int c = 0; c < 4; ++c)
#pragma unroll
        for (int g4 = 0; g4 < 4; ++g4) {
          const uint2 w = of[(c * 4 + g4) * 64];
          a.o[c][4 * g4 + 0] = a.o[c][4 * g4 + 0] * g1 + g0 * bflo(w.x);
          a.o[c][4 * g4 + 1] = a.o[c][4 * g4 + 1] * g1 + g0 * bfhi(w.x);
          a.o[c][4 * g4 + 2] = a.o[c][4 * g4 + 2] * g1 + g0 * bflo(w.y);
          a.o[c][4 * g4 + 3] = a.o[c][4 * g4 + 3] * g1 + g0 * bfhi(w.y);
        }
    }
    cols_to_lds(a, 1.f, wl, lane);
    if (h == 0) reinterpret_cast<float2*>(wl + 8192)[u] = make_float2(0.f, g2);
    int l3 = lane; asm volatile("" : "+v"(l3));
    const int srow = l3 >> 4, sch = l3 & 15;
#pragma unroll
    for (int i = 0; i < 8; ++i) {
      const int row = srow + 4 * i;
      const uint4 v = lds_row_chunk(wl, row, sch);
      const float2 gg = reinterpret_cast<const float2*>(wl + 8192)[row];
      const size_t ro = (tokbase + t0 + 4 * wid + (row >> 3)) * 2048 + (size_t)(8 * g + (row & 7)) * 128 + sch * 8;
      const uint4 ww = *reinterpret_cast<const uint4*>((const u16*)(p.ws + OFF_R3) + ro);
      uint4 y;
      y.x = pk2(bflo(v.x) + gg.y * bflo(ww.x), bfhi(v.x) + gg.y * bfhi(ww.x));
      y.y = pk2(bflo(v.y) + gg.y * bflo(ww.y), bfhi(v.y) + gg.y * bfhi(ww.y));
      y.z = pk2(bflo(v.z) + gg.y * bflo(ww.z), bfhi(v.z) + gg.y * bfhi(ww.z));
      y.w = pk2(bflo(v.w) + gg.y * bflo(ww.w), bfhi(v.w) + gg.y * bfhi(ww.w));
      *reinterpret_cast<uint4*>((u16*)(p.ws + OFF_YB) + ro) = y;
    }
  }
  __syncthreads();
}

DI void dil_merge(const Params& p, int gw, int nw, int lane) {
  const u16* og = (const u16*)(p.ws + OFF_OG);
  const float* lse = (const float*)(p.ws + OFF_LSE);
  u16* ya = (u16*)(p.ws + OFF_YA);
  const int hh = lane >> 4, d0 = (lane & 15) * 8;
  for (int tok = gw; tok < T_; tok += nw) {
    const float l0 = lse[((size_t)0 * T_ + tok) * 4 + hh], l1 = lse[((size_t)1 * T_ + tok) * 4 + hh], l2 = lse[((size_t)2 * T_ + tok) * 4 + hh];
    const float mx = fmaxf(l0, fmaxf(l1, l2));
    float w0 = __expf(l0 - mx), w1 = __expf(l1 - mx), w2 = __expf(l2 - mx);
    const float inv = 1.f / (w0 + w1 + w2);
    w0 *= inv; w1 *= inv; w2 *= inv;
    const uint4 a0 = *reinterpret_cast<const uint4*>(og + ((size_t)0 * T_ + tok) * 512 + hh * 128 + d0);
    const uint4 a1 = *reinterpret_cast<const uint4*>(og + ((size_t)1 * T_ + tok) * 512 + hh * 128 + d0);
    const uint4 a2 = *reinterpret_cast<const uint4*>(og + ((size_t)2 * T_ + tok) * 512 + hh * 128 + d0);
    uint4 o;
    o.x = pk2(w0 * bflo(a0.x) + w1 * bflo(a1.x) + w2 * bflo(a2.x), w0 * bfhi(a0.x) + w1 * bfhi(a1.x) + w2 * bfhi(a2.x));
    o.y = pk2(w0 * bflo(a0.y) + w1 * bflo(a1.y) + w2 * bflo(a2.y), w0 * bfhi(a0.y) + w1 * bfhi(a1.y) + w2 * bfhi(a2.y));
    o.z = pk2(w0 * bflo(a0.z) + w1 * bflo(a1.z) + w2 * bflo(a2.z), w0 * bfhi(a0.z) + w1 * bfhi(a1.z) + w2 * bfhi(a2.z));
    o.w = pk2(w0 * bflo(a0.w) + w1 * bflo(a1.w) + w2 * bflo(a2.w), w0 * bfhi(a0.w) + w1 * bfhi(a1.w) + w2 * bfhi(a2.w));
    *reinterpret_cast<uint4*>(ya + (size_t)tok * 512 + hh * 128 + d0) = o;
  }
}

DI float gelu_tanh(float x) {
  const float y = 0.7978845608028654f * (x + 0.044715f * x * x * x);
  return 0.5f * x * (1.f + tanhf(y));
}
constexpr int GSTR = 528;
DI void cmp_mlp_block(const Params& p, int layer, int item, int wid, int lane) {
  const u16* proj = (const u16*)(p.ws + OFF_PROJ);
  const int kv = item >> 6, rt = item & 63;
  const int g = rt >> 5, b = (rt >> 3) & 3, c0 = (rt & 7) * 32;
  const int u = lane & 31, h = lane >> 5;
  const u16* w1t = (const u16*)(p.ws + (kv ? OFF_W1V_T : OFF_W1K_T));
  const u16* w2t = (const u16*)(p.ws + (kv ? OFF_W2V_T : OFF_W2K_T));
  const float* pos = (kv ? p.cpv : p.cpk) + (size_t)layer * 32 * 128;
  const int ccol = (kv ? C_VC : C_KC) + g * 128;
  f32x16 hacc = zero16();
  {
    const int tokb = b * S_ + 16 * c0;
    for (int idx = wid * 64 + lane; idx < 528 * 16; idx += NTHREADS) {
      const int r = idx >> 4, ch = idx & 15;
      int tk = tokb + r; tk = tk > T_ - 1 ? T_ - 1 : tk;
      const bf16x8 v = ldg8(proj + (size_t)tk * PS + ccol + ch * 8);
      *reinterpret_cast<bf16x8*>(smem + ((r & 15) * 33 + (r >> 4)) * 272 + ch * 16) = v;
    }
  }
  __syncthreads();
  const u16* wfr = w1t + (size_t)wid * 256 * 64 * 8 + lane * 8;
#pragma unroll 2
  for (int l = 0; l < 32; ++l) {
    bf16x8 wf[8];
#pragma unroll
    for (int s2 = 0; s2 < 8; ++s2) wf[s2] = ldg8(wfr + (size_t)(l * 8 + s2) * 64 * 8);
    const char* drow = smem + ((l & 15) * 33 + (l >> 4) + u) * 272 + 16 * h;
    const float* prow = pos + l * 128 + 8 * h;
#pragma unroll
    for (int s2 = 0; s2 < 8; ++s2) {
      const uint4 dv = *reinterpret_cast<const uint4*>(drow + 32 * s2);
      const float4 p0 = *reinterpret_cast<const float4*>(prow + 16 * s2), p1 = *reinterpret_cast<const float4*>(prow + 16 * s2 + 4);
      typedef __attribute__((ext_vector_type(4))) unsigned u32x4;
      u32x4 w;
      w[0] = pk2(bflo(dv.x) + p0.x, bfhi(dv.x) + p0.y);
      w[1] = pk2(bflo(dv.y) + p0.z, bfhi(dv.y) + p0.w);
      w[2] = pk2(bflo(dv.z) + p1.x, bfhi(dv.z) + p1.y);
      w[3] = pk2(bflo(dv.w) + p1.z, bfhi(dv.w) + p1.w);
      const bf16x8 df = __builtin_bit_cast(bf16x8, w);
      hacc = MFMA32(wf[s2], df, hacc);
    }
  }
  __syncthreads();
  char* gl = smem;
#pragma unroll
  for (int g4 = 0; g4 < 4; ++g4) {
    uint2 w;
    w.x = pk2(gelu_tanh(hacc[4 * g4 + 0]), gelu_tanh(hacc[4 * g4 + 1]));
    w.y = pk2(gelu_tanh(hacc[4 * g4 + 2]), gelu_tanh(hacc[4 * g4 + 3]));
    *reinterpret_cast<uint2*>(gl + u * GSTR + (32 * wid + 8 * g4 + 4 * h) * 2) = w;
  }
  __syncthreads();
  if (wid < 2) {
    f32x16 o0 = zero16(), o1 = zero16();
#pragma unroll
    for (int ks = 0; ks < 16; ++ks) {
      const bf16x8 gf = *reinterpret_cast<const bf16x8*>(gl + u * GSTR + (16 * ks + 8 * h) * 2);
      const bf16x8 wa = ldg8(w2t + (size_t)(32 * wid + u) * 256 + 16 * ks + 8 * h);
      const bf16x8 wb = ldg8(w2t + (size_t)(32 * (wid + 2) + u) * 256 + 16 * ks + 8 * h);
      o0 = MFMA32(wa, gf, o0);
      o1 = MFMA32(wb, gf, o1);
    }
    const int cidx = c0 + u;
    if (kv == 0) {
      int tk = b * S_ + 16 * cidx + 31; tk = tk > T_ - 1 ? T_ - 1 : tk;
      const float2* cs = (const float2*)(p.ws + OFF_CS) + (size_t)tk * 64;
#pragma unroll
      for (int i = 0; i < 16; ++i) {
        const float2 cc = cs[32 * wid + crow(i, h)];
        const float x1 = o0[i], x2 = o1[i];
        o0[i] = x1 * cc.x - x2 * cc.y;
        o1[i] = x2 * cc.x + x1 * cc.y;
      }
    }
    u16* dst = (u16*)(p.ws + (kv ? OFF_VCMP : OFF_KCMP)) + ((size_t)(b * 256 + cidx) * 2 + g) * 128;
#pragma unroll
    for (int g4 = 0; g4 < 4; ++g4) {
      uint2 w;
      w.x = pk2(o0[4 * g4 + 0], o0[4 * g4 + 1]); w.y = pk2(o0[4 * g4 + 2], o0[4 * g4 + 3]);
      *reinterpret_cast<uint2*>(dst + 32 * wid + 8 * g4 + 4 * h) = w;
      w.x = pk2(o1[4 * g4 + 0], o1[4 * g4 + 1]); w.y = pk2(o1[4 * g4 + 2], o1[4 * g4 + 3]);
      *reinterpret_cast<uint2*>(dst + 32 * (wid + 2) + 8 * g4 + 4 * h) = w;
    }
  }
  __syncthreads();
}

constexpr int PH_PER_LAYER = 10;
constexpr int N_PHASES = 2 * PH_PER_LAYER + 1;

DI void run_phase(const Params& p, int ph, int tid, int rep, const int bid, const int nb) {
  const int lane = tid & 63, wid = tid >> 6;
  const int gw = bid * 8 + wid, nw = nb * 8;
  char* vlds = smem + wid * (32 * 272 + VTILE_B);
  if (ph == 2 * PH_PER_LAYER) { rmsnorm_f32_inplace(p.out, p.ln_final, gw, nw, lane); return; }
  const int layer = ph / PH_PER_LAYER, sub = ph % PH_PER_LAYER;
  const float* xin = layer == 0 ? p.x : p.out;
  switch (sub) {
    case 0: {
      {
        const float* w = p.w_in + (size_t)layer * 2048 * NIN;
        auto src = [=](int np) -> const float* { const int cp = np & 127; const int n = (np & ~127) + ((cp >> 5) * 16 + (cp & 15)) + 64 * ((cp >> 4) & 1);
          return n < 8192 ? w + n : (n < 12288 ? w + n + 48 : (n < 12336 ? w + n - 4096 : nullptr)); };
        tconv((u16*)(p.ws + OFF_WIN_T), 2048, NINP, NIN, src, bid, nb, tid);
      }
      { const float* w = p.woa + (size_t)layer * 512 * 2048; auto src = [=](int n) -> const float* { return w + n; };
        tconv((u16*)(p.ws + OFF_WOA_T), 512, 2048, 2048, src, bid, nb, tid); }
      { const float* w = p.wob + (size_t)layer * 2048 * 2048; auto src = [=](int n) -> const float* { return w + n; };
        tconv((u16*)(p.ws + OFF_WOB_T), 2048, 2048, 2048, src, bid, nb, tid); }
      { const float* w = p.wo + (size_t)layer * 2048 * 2048; auto src = [=](int n) -> const float* { return w + n; };
        tconv((u16*)(p.ws + OFF_WO_T), 2048, 2048, 2048, src, bid, nb, tid); }
      conv_w1frag((u16*)(p.ws + OFF_W1K_T), p.w1k + (size_t)layer * 4096 * 256, bid * NTHREADS + tid, nb * NTHREADS);
      conv_w1frag((u16*)(p.ws + OFF_W1V_T), p.w1v + (size_t)layer * 4096 * 256, bid * NTHREADS + tid, nb * NTHREADS);
      { const float* w = p.w2k + (size_t)layer * 256 * 128; auto src = [=](int n) -> const float* { return w + n; };
        tconv((u16*)(p.ws + OFF_W2K_T), 256, 128, 128, src, bid, nb, tid); }
      { const float* w = p.w2v + (size_t)layer * 256 * 128; auto src = [=](int n) -> const float* { return w + n; };
        tconv((u16*)(p.ws + OFF_W2V_T), 256, 128, 128, src, bid, nb, tid); }
      if (layer == 0) {
        float2* cs = (float2*)(p.ws + OFF_CS);
        const float inv = powf(10000.0f, -2.0f * (float)lane / 128.0f);
        for (int tok = gw; tok < T_; tok += nw) {
          const float ang = (float)p.pos[tok] * inv;
          float sn, cn; sincosf(ang, &sn, &cn);
          cs[(size_t)tok * 64 + lane] = make_float2(cn, sn);
        }
      }
      rmsnorm_bf16(xin, p.ln_mix + (size_t)layer * 2048, (u16*)(p.ws + OFF_R2), gw, nw, lane);
    } break;
    case 1: gemm_proj(p, bid, nb, tid); break;
    case 2: {
      for (int it = bid; it < 128; it += nb) cmp_mlp_block(p, layer, it, wid, lane);
      if (nb == 256) {
        if (gw < 1024) { for (int k = 0; k < 2; ++k) dil_item(p, gw * 2 + k, vlds, lane); }
        else { for (int k = 0; k < 4; ++k) dil_item(p, 2048 + (gw - 1024) * 4 + k, vlds, lane); }
      } else {
        for (int it = gw; it < 6144; it += nw) dil_item(p, it, vlds, lane);
      }
    } break;
    case 3: {
      for (int it = bid; it < 1024; it += nb) win_block(p, it, tid, wid, lane);
      for (int sit = bid; sit < 256; sit += nb) cmp_block(p, sit, tid, wid, lane);
    } break;
    case 4: {
      for (int it = bid; it < 1024; it += nb) slc_block(p, it, tid, wid, lane);
      dil_merge(p, gw, nw, lane);
    } break;
    case 5: gemm_merge(p, bid, nb, tid); break;
    case 6: gemm_resid((const u16*)(p.ws + OFF_R3), (const u16*)(p.ws + OFF_WO_T), 2048, xin, rep ? (float*)(p.ws + OFF_PROJ) : p.out, bid, nb, tid); break;
    case 7: {
      {
        const float* wgp = p.wg + (size_t)layer * 2048 * DFF; const float* wup = p.wu + (size_t)layer * 2048 * DFF;
        auto src = [=](int n) -> const float* { const int pt = n >> 8, r = n & 255; return r < 128 ? wgp + pt * 128 + r : wup + pt * 128 + (r - 128); };
        tconv((u16*)(p.ws + OFF_WGU_T), 2048, 11264, DFF, src, bid, nb, tid);
      }
      { const float* w = p.wd + (size_t)layer * DFF * 2048; auto src = [=](int n) -> const float* { return w + n; };
        tconv((u16*)(p.ws + OFF_WD_T), DFF, 2048, 2048, src, bid, nb, tid); }
      rmsnorm_bf16(p.out, p.ln_ffn + (size_t)layer * 2048, (u16*)(p.ws + OFF_R2), gw, nw, lane);
    } break;
    case 8: gemm_gateup(p, bid, nb, tid); break;
    case 9: gemm_resid((const u16*)(p.ws + OFF_PROJ), (const u16*)(p.ws + OFF_WD_T), DFF, p.out, rep ? (float*)(p.ws + OFF_R2) : p.out, bid, nb, tid); break;
  }
}

DI unsigned bar_ld(unsigned* p) { return __hip_atomic_load(p, __ATOMIC_RELAXED, __HIP_MEMORY_SCOPE_AGENT); }
DI unsigned bar_add(unsigned* p) { return __hip_atomic_fetch_add(p, 1u, __ATOMIC_RELAXED, __HIP_MEMORY_SCOPE_AGENT); }
DI void fast_grid_sync(unsigned* bar, const unsigned k, const unsigned nb, const unsigned bid, int tid) {
  asm volatile("s_waitcnt vmcnt(0) lgkmcnt(0)" ::: "memory");
  __syncthreads();
  if (tid == 0) {
    __builtin_amdgcn_fence(__ATOMIC_RELEASE, "agent");
    asm volatile("s_waitcnt vmcnt(0)" ::: "memory");
    const unsigned g = bid & 7u, gsz = nb >> 3;
    unsigned spins = 0;
    const unsigned old = bar_add(bar + 64 * g);
    bool last = false;
    if (old + 1u == k * gsz) last = (bar_add(bar + 64 * 16) + 1u == k * 8u);
    if (!last) while (bar_ld(bar + 64 * 16) < k * 8u && ++spins < (1u << 22)) __builtin_amdgcn_s_sleep(1);
    __builtin_amdgcn_fence(__ATOMIC_ACQUIRE, "agent");
    asm volatile("s_waitcnt vmcnt(0)" ::: "memory");
  }
  __syncthreads();
}

__global__ void __launch_bounds__(NTHREADS) fwd_kernel(Params p, int ph0, int ph1) {
  if (ph1 < 0) cg::this_grid().sync();
  const int widx = __builtin_amdgcn_readfirstlane((int)(threadIdx.x >> 6));
  unsigned nbar = 0;
  for (int pi = ph0; pi < ph1; ++pi) {
    int ph = pi, rep = 0;
    if (N_PROBE > 0 && pi >= N_PHASES) { ph = (pi == N_PHASES) ? PROBE_A : PROBE_B; rep = 1; }
    int tid;
    asm volatile("v_mbcnt_lo_u32_b32 %0, -1, 0\n\tv_mbcnt_hi_u32_b32 %0, -1, %0\n\tv_lshl_add_u32 %0, %1, 6, %0" : "=&v"(tid) : "s"(widx));
    int bid_ = blockIdx.x, nb_ = gridDim.x;
    asm volatile("" : "+s"(bid_), "+s"(nb_));
    run_phase(p, ph, tid, rep, bid_, nb_);
    if (pi + 1 < ph1) {
      ++nbar; fast_grid_sync(reinterpret_cast<unsigned*>(p.ws + OFF_BAR), nbar, gridDim.x, blockIdx.x, tid);
    }
  }
}

extern "C" void kernel_launch(void* const* d_in, const int* in_sizes, int n_in, void* d_out, int out_size, void* d_ws,
                              size_t ws_size, hipStream_t stream) {
  if (n_in != 18 || ws_size < WS_END) { fprintf(stderr, "kernel_launch: unexpected n_in %d or ws_size %zu < %zu\n", n_in, ws_size, (size_t)WS_END); return; }
  Params p{};
  p.x = (const float*)d_in[0]; p.pos = (const int*)d_in[1]; p.ln_mix = (const float*)d_in[2]; p.w_in = (const float*)d_in[3];
  p.cpk = (const float*)d_in[4]; p.cpv = (const float*)d_in[5]; p.w1k = (const float*)d_in[6]; p.w2k = (const float*)d_in[7];
  p.w1v = (const float*)d_in[8]; p.w2v = (const float*)d_in[9]; p.woa = (const float*)d_in[10]; p.wob = (const float*)d_in[11];
  p.wo = (const float*)d_in[12]; p.ln_ffn = (const float*)d_in[13]; p.wg = (const float*)d_in[14]; p.wu = (const float*)d_in[15];
  p.wd = (const float*)d_in[16]; p.ln_final = (const float*)d_in[17];
  p.out = (float*)d_out; p.ws = (char*)d_ws;
  static int grid_blocks = 0;
  if (!grid_blocks) {
    int dev = 0, cus = 0, per_cu = 0;
    hipGetDevice(&dev);
    hipDeviceGetAttribute(&cus, hipDeviceAttributeMultiprocessorCount, dev);
    hipOccupancyMaxActiveBlocksPerMultiprocessor(&per_cu, fwd_kernel, NTHREADS, 0);
    if (per_cu < 1) per_cu = 1;
    if (per_cu > 1) per_cu = 1;
    grid_blocks = cus * per_cu;
    if (grid_blocks % 8) grid_blocks -= grid_blocks % 8;
  }
#if MULTI_LAUNCH
  for (int ph = 0; ph < N_PHASES; ++ph) {
    hipLaunchKernelGGL(fwd_kernel, dim3(grid_blocks), dim3(NTHREADS), 0, stream, p, ph, ph + 1);
  }
#else
  int ph0 = 0, ph1 = N_PHASES + N_PROBE;
  (void)hipMemsetAsync((char*)d_ws + OFF_BAR, 0, 8192, stream);
  void* args[] = {&p, &ph0, &ph1};
  hipError_t e = hipLaunchCooperativeKernel((void*)fwd_kernel, dim3(grid_blocks), dim3(NTHREADS), args, 0, stream);
  if (e != hipSuccess) fprintf(stderr, "cooperative launch failed: %s (grid %d)\n", hipGetErrorString(e), grid_blocks);
#endif
}
```

```cpp
#include <hip/hip_runtime.h>
#include <hip/hip_cooperative_groups.h>
#include <cstdio>
#include <cstdint>
namespace cg = cooperative_groups;

#define PROBE_A -1
#define PROBE_B -1
#define N_PROBE ((PROBE_A >= 0 ? 1 : 0) + (PROBE_B >= 0 ? 1 : 0))
#ifndef MULTI_LAUNCH
#define MULTI_LAUNCH 0
#endif

typedef unsigned short u16;
typedef __attribute__((ext_vector_type(8))) short bf16x8;
typedef __attribute__((ext_vector_type(4))) short s16x4;
typedef __attribute__((ext_vector_type(4))) float f32x4;
typedef __attribute__((ext_vector_type(16))) float f32x16;
typedef __attribute__((ext_vector_type(2))) float f32x2_t;
typedef __attribute__((ext_vector_type(2))) __bf16 bf16x2_t;

#define DI __device__ __forceinline__
#define MFMA32(a, b, c) __builtin_amdgcn_mfma_f32_32x32x16_bf16((a), (b), (c), 0, 0, 0)

constexpr int T_ = 16384, S_ = 4096, NB_ = 4, D_ = 2048, NIN = 12336, PS = 12352, NINP = 12544, DFF = 5632;
constexpr int C_QA = 0, C_KA = 1536, C_VA = 3072, C_QB = 4608, C_KC = 6656, C_VC = 6912, C_KS = 7168, C_VS = 7424,
              C_KW = 7680, C_VW = 7936, C_GA = 8192, C_GB = 10240, C_GN = 12288;
constexpr float SCALE = 0.08838834764831845f;
constexpr float NEG = -1e30f;
constexpr int NTHREADS = 512;
constexpr int VSTRIDE = 288;
constexpr int VTILE_B = 32 * VSTRIDE;

constexpr size_t OFF_WIN_T = 0;
constexpr size_t OFF_PSUM = OFF_WIN_T;
constexpr size_t OFF_YA = OFF_WIN_T + 33554432;
constexpr size_t OFF_WOA_T = OFF_WIN_T + (size_t)NINP * 2048 * 2;
constexpr size_t OFF_WOB_T = OFF_WOA_T + (size_t)2048 * 512 * 2;
constexpr size_t OFF_WO_T = OFF_WOB_T + (size_t)2048 * 2048 * 2;
constexpr size_t OFF_W1K_T = OFF_WO_T + (size_t)2048 * 2048 * 2;
constexpr size_t OFF_W1V_T = OFF_W1K_T + (size_t)256 * 4096 * 2;
constexpr size_t OFF_W2K_T = OFF_W1V_T + (size_t)256 * 4096 * 2;
constexpr size_t OFF_W2V_T = OFF_W2K_T + (size_t)128 * 256 * 2;
constexpr size_t OFF_PROJ = OFF_W2V_T + (size_t)128 * 256 * 2;
constexpr size_t OFF_R2 = OFF_PROJ + (size_t)T_ * PS * 2;
constexpr size_t OFF_R3 = OFF_R2 + (size_t)T_ * 2048 * 2;
constexpr size_t OFF_YB = OFF_R3 + (size_t)T_ * 2048 * 2;
constexpr size_t OFF_OG = OFF_YB + (size_t)T_ * 2048 * 2;
constexpr size_t OFF_LSE = OFF_OG + (size_t)3 * T_ * 512 * 2;
constexpr size_t OFF_WGU_T = OFF_YB;
constexpr size_t OFF_WD_T = OFF_WGU_T + (size_t)11264 * 2048 * 2;
constexpr size_t OFF_CS = OFF_LSE + (size_t)3 * T_ * 4 * 4;
constexpr size_t OFF_KCMP = OFF_CS + (size_t)T_ * 64 * 8;
constexpr size_t OFF_VCMP = OFF_KCMP + (size_t)4 * 256 * 2 * 128 * 2;
constexpr size_t OFF_KV4 = OFF_VCMP + (size_t)4 * 256 * 2 * 128 * 2;
constexpr size_t OFF_BAR = OFF_KV4 + (size_t)4 * T_ * 2 * 128 * 2;
constexpr size_t WS_END = OFF_BAR + 8192;
static_assert(OFF_WD_T + (size_t)2048 * 5632 * 2 <= OFF_CS, "ffn weight alias overflow");
static_assert(OFF_YA + (size_t)T_ * 512 * 2 <= OFF_WOA_T, "ya alias overflow");

struct Params {
  const float* x; const int* pos; const float* ln_mix; const float* w_in; const float* cpk; const float* cpv;
  const float* w1k; const float* w2k; const float* w1v; const float* w2v; const float* woa; const float* wob;
  const float* wo; const float* ln_ffn; const float* wg; const float* wu; const float* wd; const float* ln_final;
  float* out; char* ws;
};

__shared__ __attribute__((aligned(16))) char smem[147456];

DI unsigned pk2(float a, float b) {
  f32x2_t v = {a, b};
  bf16x2_t r = __builtin_convertvector(v, bf16x2_t);
  return __builtin_bit_cast(unsigned, r);
}
DI float bf2f(u16 b) { return __uint_as_float(((unsigned)b) << 16); }
DI float bflo(unsigned w) { return __uint_as_float(w << 16); }
DI float bfhi(unsigned w) { return __uint_as_float(w & 0xffff0000u); }
DI u16 f2bf(float a) { return (u16)(pk2(a, 0.f) & 0xffffu); }
DI bf16x8 ldg8(const u16* p) { return *reinterpret_cast<const bf16x8*>(p); }
DI float wave_sum(float v) {
#pragma unroll
  for (int o = 32; o >= 1; o >>= 1) v += __shfl_xor(v, o);
  return v;
}
DI float sigmoidf_(float v) { return __builtin_amdgcn_rcpf(1.f + __expf(-v)); }
DI int crow(int i, int h) { return (i & 3) + 8 * (i >> 2) + 4 * h; }
DI f32x16 zero16() { f32x16 z;
#pragma unroll
  for (int i = 0; i < 16; ++i) z[i] = 0.f; return z; }
DI bf16x8 pack8(const f32x16& x, int s) {
  unsigned w0 = pk2(x[8 * s + 0], x[8 * s + 1]), w1 = pk2(x[8 * s + 2], x[8 * s + 3]);
  unsigned w2 = pk2(x[8 * s + 4], x[8 * s + 5]), w3 = pk2(x[8 * s + 6], x[8 * s + 7]);
  typedef __attribute__((ext_vector_type(4))) unsigned u32x4;
  u32x4 p = {w0, w1, w2, w3};
  return __builtin_bit_cast(bf16x8, p);
}

template <class SRC>
DI void tconv(u16* __restrict__ dst, int K, int Npad, int ldsrc, SRC src, int bid, int nb, int tid) {
  float* tile = (float*)smem;
  const int nk = K / 128, nn = Npad / 128, ntile = nk * nn;
  float4 v[8];
  auto load_tile = [&](int t) {
    const int kt = t % nk, nt = t / nk, k0 = kt * 128, n0 = nt * 128;
#pragma unroll
    for (int e = 0; e < 8; ++e) {
      const int idx = tid + 512 * e, kk = idx >> 5, n4 = (idx & 31) * 4;
      const float* cp = src(n0 + n4);
      v[e] = cp ? *reinterpret_cast<const float4*>(cp + (size_t)(k0 + kk) * ldsrc) : make_float4(0.f, 0.f, 0.f, 0.f);
    }
  };
  if (bid < ntile) load_tile(bid);
  for (int t = bid; t < ntile; t += nb) {
    const int kt = t % nk, nt = t / nk, k0 = kt * 128, n0 = nt * 128;
#pragma unroll
    for (int e = 0; e < 8; ++e) {
      const int idx = tid + 512 * e, kk = idx >> 5, n4 = (idx & 31) * 4;
      float* tp = tile + kk * 129 + n4;
      tp[0] = v[e].x; tp[1] = v[e].y; tp[2] = v[e].z; tp[3] = v[e].w;
    }
    if (t + nb < ntile) load_tile(t + nb);
    __syncthreads();
#pragma unroll
    for (int e = 0; e < 4; ++e) {
      const int c = tid + 512 * e;
      const int nl = (c & 7) + 8 * (c >> 7), kc = ((c >> 3) & 15) * 8;
      const float* tp = tile + kc * 129 + nl;
      uint4 w;
      w.x = pk2(tp[0 * 129], tp[1 * 129]);
      w.y = pk2(tp[2 * 129], tp[3 * 129]);
      w.z = pk2(tp[4 * 129], tp[5 * 129]);
      w.w = pk2(tp[6 * 129], tp[7 * 129]);
      *reinterpret_cast<uint4*>(dst + (size_t)(n0 + nl) * K + k0 + kc) = w;
    }
    __syncthreads();
  }
}

DI void conv_w1frag(u16* __restrict__ dst, const float* __restrict__ w1, int gtid, int nthr) {
  for (int it = gtid; it < 8 * 256 * 64; it += nthr) {
    const int ln = it & 63, ks = (it >> 6) & 255, nbk = it >> 14;
    const float* sp = w1 + (size_t)(16 * ks + 8 * (ln >> 5)) * 256 + 32 * nbk + (ln & 31);
    uint4 w;
    w.x = pk2(sp[0 * 256], sp[1 * 256]); w.y = pk2(sp[2 * 256], sp[3 * 256]);
    w.z = pk2(sp[4 * 256], sp[5 * 256]); w.w = pk2(sp[6 * 256], sp[7 * 256]);
    *reinterpret_cast<uint4*>(dst + (size_t)it * 8) = w;
  }
}

DI void rmsnorm_bf16(const float* __restrict__ x, const float* __restrict__ g, u16* __restrict__ h, int gw, int nw, int lane) {
  for (int row = gw; row < T_; row += nw) {
    const float4* xr = reinterpret_cast<const float4*>(x + (size_t)row * D_);
    float4 v[8];
    float ss = 0.f;
#pragma unroll
    for (int i = 0; i < 8; ++i) { v[i] = xr[lane + 64 * i]; ss += v[i].x * v[i].x + v[i].y * v[i].y + v[i].z * v[i].z + v[i].w * v[i].w; }
    ss = wave_sum(ss);
    const float rs = rsqrtf(ss * (1.f / 2048.f) + 1e-6f);
    uint2* hr = reinterpret_cast<uint2*>(h + (size_t)row * D_);
#pragma unroll
    for (int i = 0; i < 8; ++i) {
      const float4 gg = reinterpret_cast<const float4*>(g)[lane + 64 * i];
      uint2 o;
      o.x = pk2(v[i].x * rs * gg.x, v[i].y * rs * gg.y);
      o.y = pk2(v[i].z * rs * gg.z, v[i].w * rs * gg.w);
      hr[lane + 64 * i] = o;
    }
  }
}
DI void rmsnorm_f32_inplace(float* __restrict__ x, const float* __restrict__ g, int gw, int nw, int lane) {
  for (int row = gw; row < T_; row += nw) {
    float4* xr = reinterpret_cast<float4*>(x + (size_t)row * D_);
    float4 v[8];
    float ss = 0.f;
#pragma unroll
    for (int i = 0; i < 8; ++i) { v[i] = xr[lane + 64 * i]; ss += v[i].x * v[i].x + v[i].y * v[i].y + v[i].z * v[i].z + v[i].w * v[i].w; }
    ss = wave_sum(ss);
    const float rs = rsqrtf(ss * (1.f / 2048.f) + 1e-6f);
#pragma unroll
    for (int i = 0; i < 8; ++i) {
      const float4 gg = reinterpret_cast<const float4*>(g)[lane + 64 * i];
      float4 o;
      o.x = v[i].x * rs * gg.x; o.y = v[i].y * rs * gg.y; o.z = v[i].z * rs * gg.z; o.w = v[i].w * rs * gg.w;
      xr[lane + 64 * i] = o;
    }
  }
}

constexpr int BM = 256, BK = 64, HALF = 128, NXCD = 8, WGM = 8, HT = HALF * BK;

DI int lds_byte(int r, int c) {
  int st = (r >> 4) * 2 + (c >> 5), rr = r & 15, cc = c & 31, ob = rr * 64 + cc * 2;
  return st * 1024 + (ob ^ (((ob >> 9) & 1) << 5));
}
DI void stage_rc(int b, int& R, int& C) {
  int st = b / 1024, sb = b % 1024, swz = sb ^ (((sb >> 9) & 1) << 5);
  R = (st >> 1) * 16 + swz / 64; C = (st & 1) * 32 + (swz % 64) / 2;
}

typedef f32x4 GemmAcc[2][2][4][2];

DI void gemm_kloop(const u16* __restrict__ A, const u16* __restrict__ Bt, const int K, const int brow, const int bcol, GemmAcc& acc, const int tid) {
  u16* shm = reinterpret_cast<u16*>(smem);
#define SA(b, h) (shm + ((b) * 2 + (h)) * HT)
#define SB(b, h) (shm + (4 + (b) * 2 + (h)) * HT)
#define STAGE(P, BASE, br, kt) do { const unsigned _ub = (unsigned)(((br) * K + (kt) * BK) * 2); \
    __builtin_amdgcn_global_load_lds((const unsigned*)((const char*)(BASE) + (size_t)(_ub + so0)), \
        (unsigned*)((char*)(P) + tid * 16), 16, 0, 0); \
    __builtin_amdgcn_global_load_lds((const unsigned*)((const char*)(BASE) + (size_t)(_ub + so1)), \
        (unsigned*)((char*)(P) + tid * 16 + 8192), 16, 0, 0); } while (0)
#define LDA(dst, b, h) for (int m = 0; m < 4; ++m) for (int k = 0; k < 2; ++k) \
    dst[m][k] = *reinterpret_cast<const bf16x8*>((char*)SA(b, h) + aoff + m * 2048 + k * 1024)
#define LDB(dst, b, h) for (int n = 0; n < 2; ++n) for (int k = 0; k < 2; ++k) \
    dst[n][k] = *reinterpret_cast<const bf16x8*>((char*)SB(b, h) + boff + n * 2048 + k * 1024)
#define MMA(ai, bj, At, Bt_) do { __builtin_amdgcn_s_setprio(1); \
    for (int m = 0; m < 4; ++m) for (int n = 0; n < 2; ++n) for (int k = 0; k < 2; ++k) \
      acc[ai][bj][m][n] = __builtin_amdgcn_mfma_f32_16x16x32_bf16(Bt_[n][k], At[m][k], acc[ai][bj][m][n], 0, 0, 0); \
    __builtin_amdgcn_s_setprio(0); } while (0)
#define WAIT_V(n) asm volatile("s_waitcnt vmcnt(" #n ")" ::: "memory")
#define WAIT_L(n) asm volatile("s_waitcnt lgkmcnt(" #n ")" ::: "memory")
#define BAR __builtin_amdgcn_s_barrier()
#define SCHED __builtin_amdgcn_sched_barrier(0)
  const int wid = tid >> 6, lane = tid & 63, wr = wid >> 2, wc = wid & 3, fr = lane & 15, fq = lane >> 4;
  bf16x8 At[4][2], B0[2][2], B1[2][2];
  unsigned so0, so1;
  { int r0, c0; stage_rc(tid * 16, r0, c0); so0 = (unsigned)((r0 * K + c0) * 2); so1 = so0 + (unsigned)(64 * K * 2); }
  const int lanepart = lds_byte(fr, fq * 8);
  const int aoff = wr * 8192 + lanepart, boff = wc * 4096 + lanepart;
  const int nt = K / BK;
  STAGE(SB(0, 0), Bt, bcol, 0); STAGE(SA(0, 0), A, brow, 0);
  STAGE(SB(0, 1), Bt, bcol + HALF, 0); STAGE(SA(0, 1), A, brow + HALF, 0);
  if (wr == 1) BAR;
  WAIT_V(4); BAR;
  STAGE(SB(1, 0), Bt, bcol, 1); STAGE(SA(1, 0), A, brow, 1); STAGE(SB(1, 1), Bt, bcol + HALF, 1);
  WAIT_V(6); BAR;
  for (int t = 0; t < nt - 2; t += 2) {
    LDB(B0, 0, 0); SCHED; LDA(At, 0, 0); STAGE(SA(1, 1), A, brow + HALF, t + 1);
    WAIT_L(8); BAR; WAIT_L(0); MMA(0, 0, At, B0); BAR; SCHED;
    LDB(B1, 0, 1); STAGE(SB(0, 0), Bt, bcol, t + 2);
    BAR; WAIT_L(0); MMA(0, 1, At, B1); BAR;
    LDA(At, 0, 1); STAGE(SA(0, 0), A, brow, t + 2);
    BAR; WAIT_L(0); MMA(1, 0, At, B0); BAR; SCHED;
    STAGE(SB(0, 1), Bt, bcol + HALF, t + 2);
    WAIT_V(6); BAR; MMA(1, 1, At, B1); BAR;
    LDB(B0, 1, 0); SCHED; LDA(At, 1, 0); STAGE(SA(0, 1), A, brow + HALF, t + 2);
    WAIT_L(8); BAR; WAIT_L(0); MMA(0, 0, At, B0); BAR; SCHED;
    LDB(B1, 1, 1); STAGE(SB(1, 0), Bt, bcol, t + 3);
    BAR; WAIT_L(0); MMA(0, 1, At, B1); BAR;
    LDA(At, 1, 1); STAGE(SA(1, 0), A, brow, t + 3);
    BAR; WAIT_L(0); MMA(1, 0, At, B0); BAR; SCHED;
    STAGE(SB(1, 1), Bt, bcol + HALF, t + 3);
    WAIT_V(6); BAR; MMA(1, 1, At, B1); BAR;
  }
  { LDB(B0, 0, 0); LDA(At, 0, 0); STAGE(SA(1, 1), A, brow + HALF, nt - 1);
    BAR; WAIT_L(0); MMA(0, 0, At, B0); BAR;
    LDB(B1, 0, 1); BAR; WAIT_L(0); MMA(0, 1, At, B1); BAR;
    LDA(At, 0, 1); WAIT_V(4); BAR; WAIT_L(0); MMA(1, 0, At, B0); MMA(1, 1, At, B1); BAR; }
  { LDB(B0, 1, 0); LDA(At, 1, 0); WAIT_V(2); BAR; WAIT_L(0); MMA(0, 0, At, B0); BAR;
    LDB(B1, 1, 1); WAIT_V(0); BAR; WAIT_L(0); MMA(0, 1, At, B1); BAR;
    LDA(At, 1, 1); BAR; WAIT_L(0); MMA(1, 0, At, B0); MMA(1, 1, At, B1); BAR; }
  if (wr == 0) BAR;
}

#define PAIR(BR1, BC1, T1, BR2, BC2, T2, T3) \
    LDB(B0, 0, 0); SCHED; LDA(At, 0, 0); STAGE(SA(1, 1), A, (BR1) + HALF, T1); \
    WAIT_L(8); BAR; WAIT_L(0); MMA(0, 0, At, B0); BAR; SCHED; \
    LDB(B1, 0, 1); STAGE(SB(0, 0), Bt, BC2, T2); \
    BAR; WAIT_L(0); MMA(0, 1, At, B1); BAR; \
    LDA(At, 0, 1); STAGE(SA(0, 0), A, BR2, T2); \
    BAR; WAIT_L(0); MMA(1, 0, At, B0); BAR; SCHED; \
    STAGE(SB(0, 1), Bt, (BC2) + HALF, T2); \
    WAIT_V(6); BAR; MMA(1, 1, At, B1); BAR; \
    LDB(B0, 1, 0); SCHED; LDA(At, 1, 0); STAGE(SA(0, 1), A, (BR2) + HALF, T2); \
    WAIT_L(8); BAR; WAIT_L(0); MMA(0, 0, At, B0); BAR; SCHED; \
    LDB(B1, 1, 1); STAGE(SB(1, 0), Bt, BC2, T3); \
    BAR; WAIT_L(0); MMA(0, 1, At, B1); BAR; \
    LDA(At, 1, 1); STAGE(SA(1, 0), A, BR2, T3); \
    BAR; WAIT_L(0); MMA(1, 0, At, B0); BAR; SCHED; \
    STAGE(SB(1, 1), Bt, (BC2) + HALF, T3); \
    WAIT_V(6); BAR; MMA(1, 1, At, B1); BAR;

__device__ __forceinline__ void gemm_tile_coords(int id, int nM, int nN, int& pm, int& pn);

template <class EPI>
DI void gemm_stream(const u16* __restrict__ A, const u16* __restrict__ Bt, const int K, const int nM, const int nN,
                    const int bid, const int nb, const int tid, EPI epi) {
  const int ntot = nM * nN;
  if (bid >= ntot) return;
  u16* shm = reinterpret_cast<u16*>(smem);
  const int wid = tid >> 6, lane = tid & 63, wr = wid >> 2, wc = wid & 3, fr = lane & 15, fq = lane >> 4;
  unsigned so0, so1;
  { int r0, c0; stage_rc(tid * 16, r0, c0); so0 = (unsigned)((r0 * K + c0) * 2); so1 = so0 + (unsigned)(64 * K * 2); }
  const int lanepart = lds_byte(fr, fq * 8);
  const int aoff = wr * 8192 + lanepart, boff = wc * 4096 + lanepart;
  const int nt = K / BK;
  int pm, pn; gemm_tile_coords(bid, nM, nN, pm, pn);
  int brow = pm * BM, bcol = pn * BM;
  GemmAcc acc = {};
  STAGE(SB(0, 0), Bt, bcol, 0); STAGE(SA(0, 0), A, brow, 0);
  STAGE(SB(0, 1), Bt, bcol + HALF, 0); STAGE(SA(0, 1), A, brow + HALF, 0);
  if (wr == 1) BAR;
  WAIT_V(4); BAR;
  STAGE(SB(1, 0), Bt, bcol, 1); STAGE(SA(1, 0), A, brow, 1); STAGE(SB(1, 1), Bt, bcol + HALF, 1);
  WAIT_V(6); BAR;
  for (int id = bid; id < ntot; id += nb) {
    const int idn = id + nb;
    int pm2 = pm, pn2 = pn;
    if (idn < ntot) gemm_tile_coords(idn, nM, nN, pm2, pn2);
    const int brow2 = pm2 * BM, bcol2 = pn2 * BM;
    for (int t = 0; t < nt; t += 2) {
      const bool inside = (t + 2 < nt);
      const int brs = inside ? brow : brow2, bcs = inside ? bcol : bcol2, t2 = inside ? t + 2 : 0;
      bf16x8 At[4][2], B0[2][2], B1[2][2];
      PAIR(brow, bcol, t + 1, brs, bcs, t2, t2 + 1)
    }
    epi(acc, brow, bcol, pn);
#pragma unroll
    for (int ai = 0; ai < 2; ++ai)
#pragma unroll
      for (int bj = 0; bj < 2; ++bj)
#pragma unroll
        for (int m = 0; m < 4; ++m)
#pragma unroll
          for (int n = 0; n < 2; ++n) acc[ai][bj][m][n] = (f32x4){0.f, 0.f, 0.f, 0.f};
    brow = brow2; bcol = bcol2; pm = pm2; pn = pn2;
  }
  WAIT_V(0);
  if (wr == 0) BAR;
  BAR;
}

DI void gemm_tile_coords(int id, int nM, int nN, int& pm, int& pn) {
  const int nwg = nM * nN;
  int q = nwg / NXCD, r = nwg % NXCD, xcd = id % NXCD, off = id / NXCD;
  int wgid = (xcd < r ? xcd * (q + 1) : r * (q + 1) + (xcd - r) * q) + off;
  int nig = WGM * nN, gid = wgid / nig, fm = gid * WGM, gsz = min(nM - fm, WGM);
  pm = fm + ((wgid % nig) % gsz); pn = (wgid % nig) / gsz;
}

#define ACC_FOREACH _Pragma("unroll") for (int ai = 0; ai < 2; ++ai) _Pragma("unroll") for (int bj = 0; bj < 2; ++bj) _Pragma("unroll") for (int m = 0; m < 4; ++m) _Pragma("unroll") for (int n = 0; n < 2; ++n)
#define ACC_ROW (brow + ai * HALF + wr * 64 + m * 16 + fr)
#define ACC_COL (bcol + bj * HALF + wc * 32 + n * 16 + fq * 4)
#define GEMM_IDS int tid_ = tid; asm volatile("" : "+v"(tid_)); const int wid = tid_ >> 6, lane = tid_ & 63, wr = wid >> 2, wc = wid & 3, fr = lane & 15, fq = lane >> 4; (void)lane;
#define EPI_SCHED __builtin_amdgcn_sched_barrier(0)

DI void gemm_proj(const Params& p, int bid, int nb, int tid) {
  const u16* A = (const u16*)(p.ws + OFF_R2);
  const u16* Bt = (const u16*)(p.ws + OFF_WIN_T);
  u16* C = (u16*)(p.ws + OFF_PROJ);
  const int nM = T_ / BM, nN = NINP / BM;
  gemm_stream(A, Bt, 2048, nM, nN, bid, nb, tid, [&](GemmAcc& acc, const int brow, const int bcol, const int pn) {
    GEMM_IDS
    const bool rope_tile = (pn < 12) || (pn >= 18 && pn < 26) || pn == 28 || pn == 30;
    const bool kv_tile = (pn >= 28 && pn < 32);
    const int d1 = wc * 16 + fq * 4;
    const float* cs = (const float*)(p.ws + OFF_CS);
#pragma unroll
    for (int ai = 0; ai < 2; ++ai) {
      float4 c01[4], c23[4];
#pragma unroll
      for (int m = 0; m < 4; ++m) {
        const int row = brow + ai * HALF + wr * 64 + m * 16 + fr;
        c01[m] = make_float4(1.f, 0.f, 1.f, 0.f); c23[m] = c01[m];
        if (rope_tile) {
          c01[m] = *reinterpret_cast<const float4*>(cs + ((size_t)row * 64 + d1) * 2);
          c23[m] = *reinterpret_cast<const float4*>(cs + ((size_t)row * 64 + d1) * 2 + 4);
        }
      }
#pragma unroll
      for (int m = 0; m < 4; ++m) {
        const int row = brow + ai * HALF + wr * 64 + m * 16 + fr;
#pragma unroll
        for (int bj = 0; bj < 2; ++bj) {
          const f32x4 x1 = acc[ai][bj][m][0], x2 = acc[ai][bj][m][1];
          uint2 w1, w2;
          w1.x = pk2(x1[0] * c01[m].x - x2[0] * c01[m].y, x1[1] * c01[m].z - x2[1] * c01[m].w);
          w1.y = pk2(x1[2] * c23[m].x - x2[2] * c23[m].y, x1[3] * c23[m].z - x2[3] * c23[m].w);
          w2.x = pk2(x2[0] * c01[m].x + x1[0] * c01[m].y, x2[1] * c01[m].z + x1[1] * c01[m].w);
          w2.y = pk2(x2[2] * c23[m].x + x1[2] * c23[m].y, x2[3] * c23[m].z + x1[3] * c23[m].w);
          const int col1 = bcol + bj * HALF + d1;
          if (kv_tile) {
            u16* dk = (u16*)(p.ws + OFF_KV4) + ((size_t)((((pn - 28) * 4 + (row >> 12)) * 2 + bj) * 4096 + (row & 4095))) * 128 + d1;
            *reinterpret_cast<uint2*>(dk) = w1;
            *reinterpret_cast<uint2*>(dk + 64) = w2;
          } else {
            if (col1 < PS) *reinterpret_cast<uint2*>(C + (size_t)row * PS + col1) = w1;
            if (col1 + 64 < PS) *reinterpret_cast<uint2*>(C + (size_t)row * PS + col1 + 64) = w2;
          }
        }
      }
      EPI_SCHED;
    }
  });
}

DI void gemm_merge(const Params& p, int bid, int nb, int tid) {
  const u16* A1 = (const u16*)(p.ws + OFF_YA);
  const u16* B1 = (const u16*)(p.ws + OFF_WOA_T);
  const u16* A2 = (const u16*)(p.ws + OFF_YB);
  const u16* B2 = (const u16*)(p.ws + OFF_WOB_T);
  const u16* proj = (const u16*)(p.ws + OFF_PROJ);
  u16* C = (u16*)(p.ws + OFF_R3);
  const int nM = T_ / BM, nN = 2048 / BM;
  for (int id = bid; id < nM * nN; id += nb) {
    int pm, pn; gemm_tile_coords(id, nM, nN, pm, pn);
    const int brow = pm * BM, bcol = pn * BM;
    GemmAcc acc = {};
    gemm_kloop(A1, B1, 512, brow, bcol, acc, tid);
    {
    GEMM_IDS
#pragma unroll
    for (int ai = 0; ai < 2; ++ai)
#pragma unroll
      for (int bj = 0; bj < 2; ++bj) {
        uint2 gw[4][2];
#pragma unroll
        for (int m = 0; m < 4; ++m)
#pragma unroll
          for (int n = 0; n < 2; ++n) gw[m][n] = *reinterpret_cast<const uint2*>(proj + (size_t)ACC_ROW * PS + C_GA + ACC_COL);
#pragma unroll
        for (int m = 0; m < 4; ++m)
#pragma unroll
          for (int n = 0; n < 2; ++n) {
            f32x4& v = acc[ai][bj][m][n];
            uint2 w;
            w.x = pk2(v[0] * sigmoidf_(bflo(gw[m][n].x)), v[1] * sigmoidf_(bfhi(gw[m][n].x)));
            w.y = pk2(v[2] * sigmoidf_(bflo(gw[m][n].y)), v[3] * sigmoidf_(bfhi(gw[m][n].y)));
            *reinterpret_cast<uint2*>(C + (size_t)ACC_ROW * 2048 + ACC_COL) = w;
            v[0] = 0.f; v[1] = 0.f; v[2] = 0.f; v[3] = 0.f;
          }
        EPI_SCHED;
      }
    }
    gemm_kloop(A2, B2, 2048, brow, bcol, acc, tid);
    GEMM_IDS
#pragma unroll
    for (int ai = 0; ai < 2; ++ai)
#pragma unroll
      for (int bj = 0; bj < 2; ++bj) {
        uint2 gw[4][2], old[4][2];
#pragma unroll
        for (int m = 0; m < 4; ++m)
#pragma unroll
          for (int n = 0; n < 2; ++n) {
            gw[m][n] = *reinterpret_cast<const uint2*>(proj + (size_t)ACC_ROW * PS + C_GB + ACC_COL);
            old[m][n] = *reinterpret_cast<const uint2*>(C + (size_t)ACC_ROW * 2048 + ACC_COL);
          }
#pragma unroll
        for (int m = 0; m < 4; ++m)
#pragma unroll
          for (int n = 0; n < 2; ++n) {
            const f32x4 v = acc[ai][bj][m][n];
            uint2 w;
            w.x = pk2(bflo(old[m][n].x) + v[0] * sigmoidf_(bflo(gw[m][n].x)), bfhi(old[m][n].x) + v[1] * sigmoidf_(bfhi(gw[m][n].x)));
            w.y = pk2(bflo(old[m][n].y) + v[2] * sigmoidf_(bflo(gw[m][n].y)), bfhi(old[m][n].y) + v[3] * sigmoidf_(bfhi(gw[m][n].y)));
            *reinterpret_cast<uint2*>(C + (size_t)ACC_ROW * 2048 + ACC_COL) = w;
          }
        EPI_SCHED;
      }
  }
}

DI void gemm_resid(const u16* A, const u16* Bt, int K, const float* xin, float* xout, int bid, int nb, int tid) {
  const int nM = T_ / BM, nN = 2048 / BM;
  gemm_stream(A, Bt, K, nM, nN, bid, nb, tid, [&](GemmAcc& acc, const int brow, const int bcol, const int pn) {
    (void)pn;
    GEMM_IDS
#pragma unroll
    for (int ai = 0; ai < 2; ++ai)
#pragma unroll
      for (int bj = 0; bj < 2; ++bj) {
        float4 xi[4][2];
#pragma unroll
        for (int m = 0; m < 4; ++m)
#pragma unroll
          for (int n = 0; n < 2; ++n) xi[m][n] = *reinterpret_cast<const float4*>(xin + (size_t)ACC_ROW * 2048 + ACC_COL);
#pragma unroll
        for (int m = 0; m < 4; ++m)
#pragma unroll
          for (int n = 0; n < 2; ++n) {
            const f32x4 v = acc[ai][bj][m][n];
            float4 r; r.x = xi[m][n].x + v[0]; r.y = xi[m][n].y + v[1]; r.z = xi[m][n].z + v[2]; r.w = xi[m][n].w + v[3];
            *reinterpret_cast<float4*>(xout + (size_t)ACC_ROW * 2048 + ACC_COL) = r;
          }
        EPI_SCHED;
      }
  });
}

DI void gemm_gateup(const Params& p, int bid, int nb, int tid) {
  const u16* A = (const u16*)(p.ws + OFF_R2);
  const u16* Bt = (const u16*)(p.ws + OFF_WGU_T);
  u16* C = (u16*)(p.ws + OFF_PROJ);
  const int nM = T_ / BM, nN = 11264 / BM;
  gemm_stream(A, Bt, 2048, nM, nN, bid, nb, tid, [&](GemmAcc& acc, const int brow, const int bcol, const int pn) {
    (void)bcol;
    GEMM_IDS
    _Pragma("unroll") for (int ai = 0; ai < 2; ++ai) _Pragma("unroll") for (int m = 0; m < 4; ++m) _Pragma("unroll") for (int n = 0; n < 2; ++n) {
      const int col = pn * 128 + wc * 32 + n * 16 + fq * 4;
      const int row = brow + ai * HALF + wr * 64 + m * 16 + fr;
      const f32x4 g = acc[ai][0][m][n], uu = acc[ai][1][m][n];
      uint2 w;
      w.x = pk2(g[0] * sigmoidf_(g[0]) * uu[0], g[1] * sigmoidf_(g[1]) * uu[1]);
      w.y = pk2(g[2] * sigmoidf_(g[2]) * uu[2], g[3] * sigmoidf_(g[3]) * uu[3]);
      *reinterpret_cast<uint2*>(C + (size_t)row * DFF + col) = w;
      EPI_SCHED;
    }
  });
}

struct AttnAcc { f32x16 o[4]; float m, l; };
DI void attn_init(AttnAcc& a) {
#pragma unroll
  for (int c = 0; c < 4; ++c) a.o[c] = zero16();
  a.m = NEG; a.l = 0.f;
}
DI f32x16 qk_tile(const bf16x8 (&qf)[8], const u16* kp) {
  bf16x8 kf[8];
#pragma unroll
  for (int s = 0; s < 8; ++s) kf[s] = ldg8(kp + 16 * s);
  f32x16 st = zero16();
#pragma unroll
  for (int s = 0; s < 8; ++s) st = MFMA32(kf[s], qf[s], st);
  return st;
}
template <int B>
DI void tr_read8(unsigned addr, s16x4 (&r)[8]) {
  asm volatile("ds_read_b64_tr_b16 %0, %8 offset:%9\n\tds_read_b64_tr_b16 %1, %8 offset:%10\n\t"
               "ds_read_b64_tr_b16 %2, %8 offset:%11\n\tds_read_b64_tr_b16 %3, %8 offset:%12\n\t"
               "ds_read_b64_tr_b16 %4, %8 offset:%13\n\tds_read_b64_tr_b16 %5, %8 offset:%14\n\t"
               "ds_read_b64_tr_b16 %6, %8 offset:%15\n\tds_read_b64_tr_b16 %7, %8 offset:%16\n\ts_waitcnt lgkmcnt(0)"
               : "=&v"(r[0]), "=&v"(r[1]), "=&v"(r[2]), "=&v"(r[3]), "=&v"(r[4]), "=&v"(r[5]), "=&v"(r[6]), "=&v"(r[7])
               : "v"(addr), "i"(B), "i"(8 * VSTRIDE + B), "i"(16 * VSTRIDE + B), "i"(24 * VSTRIDE + B),
                 "i"(B + 64), "i"(8 * VSTRIDE + B + 64), "i"(16 * VSTRIDE + B + 64), "i"(24 * VSTRIDE + B + 64)
               : "memory");
}
template <int C>
DI void pv_block2(f32x16& oa, f32x16& ob, unsigned vbase, const bf16x8& pf0, const bf16x8& pf1) {
  s16x4 r[8];
  tr_read8<64 * C>(vbase, r);
  const bf16x8 a0 = __builtin_shufflevector(r[0], r[1], 0, 1, 2, 3, 4, 5, 6, 7);
  const bf16x8 a1 = __builtin_shufflevector(r[2], r[3], 0, 1, 2, 3, 4, 5, 6, 7);
  const bf16x8 b0 = __builtin_shufflevector(r[4], r[5], 0, 1, 2, 3, 4, 5, 6, 7);
  const bf16x8 b1 = __builtin_shufflevector(r[6], r[7], 0, 1, 2, 3, 4, 5, 6, 7);
  oa = MFMA32(a0, pf0, oa);
  ob = MFMA32(b0, pf0, ob);
  oa = MFMA32(a1, pf1, oa);
  ob = MFMA32(b1, pf1, ob);
}
template <class VR>
DI void v_stage(VR vrow, char* vlds, int lane) {
  bf16x8 vst[8];
#pragma unroll
  for (int i = 0; i < 8; ++i) { const int nn = lane + 64 * i; vst[i] = ldg8(vrow(nn >> 4) + 8 * (nn & 15)); }
#pragma unroll
  for (int i = 0; i < 8; ++i) { const int nn = lane + 64 * i; *reinterpret_cast<bf16x8*>(vlds + VSTRIDE * (nn >> 4) + 16 * (nn & 15)) = vst[i]; }
}
DI unsigned v_base(char* vlds, int lane) {
  const int h = lane >> 5, blk = (lane >> 4) & 1, q = (lane & 15) >> 2, pp = lane & 3;
  return (unsigned)(size_t)vlds + VSTRIDE * (4 * h + q) + 32 * blk + 8 * pp;
}
DI void pv_tile(AttnAcc& a, const f32x16& pr, char* vlds, int lane) {
  const bf16x8 pf0 = pack8(pr, 0), pf1 = pack8(pr, 1);
  const unsigned vb = v_base(vlds, lane);
  asm volatile("s_waitcnt lgkmcnt(0)" ::: "memory");
  pv_block2<0>(a.o[0], a.o[1], vb, pf0, pf1);
  pv_block2<2>(a.o[2], a.o[3], vb, pf0, pf1);
}
template <class VR, class MK>
DI void attn_tile(AttnAcc& a, const bf16x8 (&qf)[8], const u16* kp, VR vrow, MK mask, char* vlds, int lane) {
  const int h = lane >> 5;
  f32x16 st = qk_tile(qf, kp);
  v_stage(vrow, vlds, lane);
  float mx = a.m;
#pragma unroll
  for (int i = 0; i < 16; ++i) {
    const float sv = mask(crow(i, h)) ? st[i] * SCALE : NEG;
    st[i] = sv; mx = fmaxf(mx, sv);
  }
  mx = fmaxf(mx, __shfl_xor(mx, 32));
  const float alpha = __expf(a.m - mx);
  a.m = mx;
  float ls = 0.f;
#pragma unroll
  for (int i = 0; i < 16; ++i) { const float pv = (st[i] > -1e29f) ? __expf(st[i] - mx) : 0.f; st[i] = pv; ls += pv; }
  a.l = a.l * alpha + ls;
#pragma unroll
  for (int c = 0; c < 4; ++c) a.o[c] *= alpha;
  pv_tile(a, st, vlds, lane);
}
DI void store_col(const AttnAcc& a, float sc, u16* dst, int h) {
#pragma unroll
  for (int c = 0; c < 4; ++c)
#pragma unroll
    for (int g4 = 0; g4 < 4; ++g4) {
      uint2 w;
      w.x = pk2(a.o[c][4 * g4 + 0] * sc, a.o[c][4 * g4 + 1] * sc);
      w.y = pk2(a.o[c][4 * g4 + 2] * sc, a.o[c][4 * g4 + 3] * sc);
      *reinterpret_cast<uint2*>(dst + 32 * c + 8 * g4 + 4 * h) = w;
    }
}

DI f32x16 qk_tile_lds(const bf16x8 (&qf)[8], const char* kr);
DI void cols_to_lds(const AttnAcc& a, float sc, char* tl, int lane) {
  asm volatile("" : "+v"(lane));
  const int u = lane & 31, h = lane >> 5;
#pragma unroll
  for (int c = 0; c < 4; ++c)
#pragma unroll
    for (int g4 = 0; g4 < 4; ++g4) {
      uint2 w;
      w.x = pk2(a.o[c][4 * g4 + 0] * sc, a.o[c][4 * g4 + 1] * sc);
      w.y = pk2(a.o[c][4 * g4 + 2] * sc, a.o[c][4 * g4 + 3] * sc);
      *reinterpret_cast<uint2*>(tl + u * 256 + (((4 * c + g4) ^ (u & 15)) << 4) + 8 * h) = w;
    }
  asm volatile("s_waitcnt lgkmcnt(0)" ::: "memory");
}
DI uint4 lds_row_chunk(const char* tl, int row, int chunk) {
  asm volatile("" : "+v"(row), "+v"(chunk));
  return *reinterpret_cast<const uint4*>(tl + row * 256 + ((chunk ^ (row & 15)) << 4));
}

DI void tile_compute32(AttnAcc& a, const bf16x8 (&qf)[8], const char* Kl, char* Vl, const int lo, const int hi, int lane) {
  const int u = lane & 31, h = lane >> 5;
  f32x16 st = qk_tile_lds(qf, Kl + u * 272 + 16 * h);
  constexpr float C2 = SCALE * 1.4426950408889634f;
  const bool empty = lo > hi;
  const unsigned span = empty ? 0u : (unsigned)(hi - lo);
  const int lo3 = empty ? (1 << 20) : lo - 4 * h;
  float mx = a.m;
#pragma unroll
  for (int i = 0; i < 16; ++i) {
    const int vc = (i & 3) + 8 * (i >> 2);
    const bool ok = (unsigned)(vc - lo3) <= span;
    const float sv = ok ? st[i] * C2 : NEG;
    st[i] = sv; mx = fmaxf(mx, sv);
  }
  mx = fmaxf(mx, __shfl_xor(mx, 32));
  const float msafe = (mx == NEG) ? 0.f : mx;
  const float alpha = __builtin_amdgcn_exp2f(a.m - msafe);
  a.m = mx;
  float ls = 0.f;
#pragma unroll
  for (int i = 0; i < 16; ++i) { const float pv = __builtin_amdgcn_exp2f(st[i] - msafe); st[i] = pv; ls += pv; }
  a.l = a.l * alpha + ls;
#pragma unroll
  for (int c = 0; c < 4; ++c) a.o[c] *= alpha;
  pv_tile(a, st, Vl, lane);
}

DI void dil_item(const Params& p, int item, char* wlds, int lane) {
  const u16* proj = (const u16*)(p.ws + OFF_PROJ);
  const int b = item / 1536, rem = item % 1536, head = rem >> 7, ti = rem & 127;
  const int gi = head >> 2, hh = head & 3;
  const int r = (gi == 0) ? 1 : (gi == 1 ? 4 : 16);
  const int tpc = (S_ / r) / 32;
  const int cres = ti / tpc, i0 = (ti % tpc) * 32;
  const int u = lane & 31, h = lane >> 5;
  const size_t tokbase = (size_t)b * S_;
  const int tq = r * (i0 + u) + cres;
  char* Kl = wlds;
  char* Vl = wlds + 32 * 272;
  bf16x8 qf[8];
  {
    const u16* qp = proj + (tokbase + tq) * PS + C_QA + head * 128 + 8 * h;
#pragma unroll
    for (int s = 0; s < 8; ++s) qf[s] = ldg8(qp + 16 * s);
  }
  const int srow = lane >> 4, sch = lane & 15;
  const int kt0 = (i0 >= 128) ? 0 : (128 - i0) >> 5;
  bf16x8 kst[8], vst[8];
  auto load_tile = [&](int kt) {
    const int kb = i0 - 128 + 32 * kt;
#pragma unroll
    for (int i = 0; i < 8; ++i) {
      int ii = kb + srow + 4 * i; ii = ii < 0 ? 0 : ii;
      const u16* rp = proj + (tokbase + (size_t)(r * ii + cres)) * PS + head * 128 + sch * 8;
      kst[i] = ldg8(rp + C_KA);
      vst[i] = ldg8(rp + C_VA);
    }
  };
  load_tile(kt0);
  AttnAcc a; attn_init(a);
  for (int kt = kt0; kt < 5; ++kt) {
#pragma unroll
    for (int i = 0; i < 8; ++i) {
      *reinterpret_cast<bf16x8*>(Kl + (srow + 4 * i) * 272 + sch * 16) = kst[i];
      *reinterpret_cast<bf16x8*>(Vl + (srow + 4 * i) * VSTRIDE + sch * 16) = vst[i];
    }
    if (kt + 1 < 5) load_tile(kt + 1);
    const int kb = i0 - 128 + 32 * kt;
    const int qi = i0 + u;
    int lo_ = qi - 128 - kb; if (lo_ < -kb) lo_ = -kb; if (lo_ < 0) lo_ = 0;
    int hi_ = qi - kb; if (hi_ > 31) hi_ = 31;
    tile_compute32(a, qf, Kl, Vl, lo_, hi_, lane);
  }
  const float lt = a.l + __shfl_xor(a.l, 32);
  cols_to_lds(a, 1.f / lt, Kl, lane);
  {
    u16* ogb = (u16*)(p.ws + OFF_OG) + ((size_t)gi * T_ + tokbase) * 512 + hh * 128;
#pragma unroll
    for (int i = 0; i < 8; ++i) {
      const int row = srow + 4 * i;
      const uint4 v = lds_row_chunk(Kl, row, sch);
      *reinterpret_cast<uint4*>(ogb + (size_t)(r * (i0 + row) + cres) * 512 + sch * 8) = v;
    }
  }
  if (h == 0) ((float*)(p.ws + OFF_LSE))[((size_t)gi * T_ + tokbase + tq) * 4 + hh] = a.m * 0.6931471805599453f + __logf(lt);
}

constexpr int CMP_KL = 256 * 272;
DI f32x16 qk_tile_lds(const bf16x8 (&qf)[8], const char* kr) {
  bf16x8 kf[8];
#pragma unroll
  for (int s = 0; s < 8; ++s) kf[s] = *reinterpret_cast<const bf16x8*>(kr + 32 * s);
  f32x16 st = zero16();
#pragma unroll
  for (int s = 0; s < 8; ++s) st = MFMA32(kf[s], qf[s], st);
  return st;
}
DI void cmp_block(const Params& p, int sit, int tid, int wid, int lane) {
  const u16* proj = (const u16*)(p.ws + OFF_PROJ);
  const u16* kcmp = (const u16*)(p.ws + OFF_KCMP);
  const u16* vcmp = (const u16*)(p.ws + OFF_VCMP);
  float* psum = (float*)(p.ws + OFF_PSUM);
  const int bg = sit & 7, slot = sit >> 3, b = bg >> 1, g = bg & 1;
  char* Kl = smem;
  char* Vl = smem + CMP_KL;
  __syncthreads();
  {
    bf16x8 tmp[8];
#pragma unroll
    for (int e = 0; e < 8; ++e) { const int idx = tid + 512 * e; tmp[e] = ldg8(kcmp + ((size_t)(b * 256 + (idx >> 4)) * 2 + g) * 128 + (idx & 15) * 8); }
#pragma unroll
    for (int e = 0; e < 8; ++e) { const int idx = tid + 512 * e; *reinterpret_cast<bf16x8*>(Kl + (idx >> 4) * 272 + (idx & 15) * 16) = tmp[e]; }
#pragma unroll
    for (int e = 0; e < 8; ++e) { const int idx = tid + 512 * e; tmp[e] = ldg8(vcmp + ((size_t)(b * 256 + (idx >> 4)) * 2 + g) * 128 + (idx & 15) * 8); }
#pragma unroll
    for (int e = 0; e < 8; ++e) { const int idx = tid + 512 * e; *reinterpret_cast<bf16x8*>(Vl + (idx >> 4) * VSTRIDE + (idx & 15) * 16) = tmp[e]; }
  }
  __syncthreads();
  const int u = lane & 31, h = lane >> 5, tl = u >> 3, rr = u & 7;
  const size_t tokbase = (size_t)b * S_;
  for (int qq = 0; qq < 4; ++qq) {
    const int q = qq == 0 ? slot : (qq == 1 ? 63 - slot : (qq == 2 ? 64 + slot : 127 - slot));
    const int t0 = 32 * q + 4 * wid;
    const int tq = t0 + tl, head = g * 8 + rr;
    bf16x8 qf[8];
    {
      const u16* qp = proj + (tokbase + tq) * PS + C_QB + head * 128 + 8 * h;
#pragma unroll
      for (int s = 0; s < 8; ++s) qf[s] = ldg8(qp + 16 * s);
    }
    const int nv = tq >= 31 ? ((tq - 31) >> 4) + 1 : 0;
    const int nvmax = (t0 + 3) >= 31 ? ((t0 + 3 - 31) >> 4) + 1 : 0;
    const int ntile = (nvmax + 31) >> 5;
    float mrun = NEG, lrun = 0.f;
    for (int kt = 0; kt < ntile; ++kt) {
      f32x16 st = qk_tile_lds(qf, Kl + (32 * kt + u) * 272 + 16 * h);
      float mx = mrun;
#pragma unroll
      for (int i = 0; i < 16; ++i) {
        const float sv = (32 * kt + crow(i, h) < nv) ? st[i] * SCALE : NEG;
        st[i] = sv; mx = fmaxf(mx, sv);
      }
      mx = fmaxf(mx, __shfl_xor(mx, 32));
      float ls = 0.f;
#pragma unroll
      for (int i = 0; i < 16; ++i) ls += (st[i] > -1e29f) ? __expf(st[i] - mx) : 0.f;
      lrun = lrun * __expf(mrun - mx) + ls;
      mrun = mx;
    }
    const float lt = lrun + __shfl_xor(lrun, 32);
    const float inv = 1.f / fmaxf(lt, 1e-30f);
    AttnAcc a; attn_init(a);
    float* psrow = psum + ((tokbase + tq) * 2 + g) * 256;
    for (int kt = 0; kt < ntile; ++kt) {
      f32x16 st = qk_tile_lds(qf, Kl + (32 * kt + u) * 272 + 16 * h);
      float psv[16];
#pragma unroll
      for (int i = 0; i < 16; ++i) {
        const bool ok = (32 * kt + crow(i, h) < nv);
        const float pv = ok ? __expf(st[i] * SCALE - mrun) * inv : 0.f;
        st[i] = pv;
        float ps = pv;
        ps += __shfl_xor(ps, 1); ps += __shfl_xor(ps, 2); ps += __shfl_xor(ps, 4);
        psv[i] = ps;
      }
      if (rr == 0) {
#pragma unroll
        for (int g4 = 0; g4 < 4; ++g4)
          *reinterpret_cast<float4*>(psrow + 32 * kt + 8 * g4 + 4 * h) = make_float4(psv[4 * g4], psv[4 * g4 + 1], psv[4 * g4 + 2], psv[4 * g4 + 3]);
      }
      pv_tile(a, st, Vl + 32 * kt * VSTRIDE, lane);
    }
    for (int kt = ntile; kt < 8; ++kt) {
      if (rr == 0) {
#pragma unroll
        for (int g4 = 0; g4 < 4; ++g4) *reinterpret_cast<float4*>(psrow + 32 * kt + 8 * g4 + 4 * h) = make_float4(0.f, 0.f, 0.f, 0.f);
      }
    }
    {
      uint2* of = reinterpret_cast<uint2*>(p.ws + OFF_R2) + ((((size_t)(b * 2 + g) * 128 + q) * 8 + wid) * 16) * 64 + lane;
#pragma unroll
      for (int c = 0; c < 4; ++c)
#pragma unroll
        for (int g4 = 0; g4 < 4; ++g4) {
          uint2 w;
          w.x = pk2(a.o[c][4 * g4 + 0], a.o[c][4 * g4 + 1]);
          w.y = pk2(a.o[c][4 * g4 + 2], a.o[c][4 * g4 + 3]);
          of[(c * 4 + g4) * 64] = w;
        }
    }
  }
  __syncthreads();
}

constexpr int KSTR = 272;
constexpr int STG_K = 64 * KSTR;
constexpr int STG_B = STG_K + 64 * VSTRIDE;
constexpr int LDS_UNION = 2 * STG_B;

DI void coop_compute(AttnAcc& a, const bf16x8 (&qf)[8], char* stg, const int lo, const int hi, int lane) {
  const int u = lane & 31, h = lane >> 5;
  f32x16 st[2];
#pragma unroll
  for (int hf = 0; hf < 2; ++hf) {
    const char* kr = stg + (32 * hf + u) * KSTR + 16 * h;
    bf16x8 kf[8];
#pragma unroll
    for (int s = 0; s < 8; ++s) kf[s] = *reinterpret_cast<const bf16x8*>(kr + 32 * s);
    st[hf] = zero16();
#pragma unroll
    for (int s = 0; s < 8; ++s) st[hf] = MFMA32(kf[s], qf[s], st[hf]);
  }
  constexpr float C2 = SCALE * 1.4426950408889634f;
  const bool full = (lo <= 0) && (hi >= 63), empty = lo > hi;
  float mx = a.m;
  if (__all(full || empty)) {
    const float cs = full ? C2 : 0.f, ad = full ? 0.f : NEG;
#pragma unroll
    for (int hf = 0; hf < 2; ++hf)
#pragma unroll
      for (int i = 0; i < 16; ++i) { const float sv = fmaf(st[hf][i], cs, ad); st[hf][i] = sv; mx = fmaxf(mx, sv); }
  } else {
    const unsigned span = empty ? 0u : (unsigned)(hi - lo);
    const int lo3 = empty ? (1 << 20) : lo - 4 * h;
#pragma unroll
    for (int hf = 0; hf < 2; ++hf)
#pragma unroll
      for (int i = 0; i < 16; ++i) {
        const int vc = 32 * hf + (i & 3) + 8 * (i >> 2);
        const bool ok = (unsigned)(vc - lo3) <= span;
        const float sv = ok ? st[hf][i] * C2 : NEG;
        st[hf][i] = sv; mx = fmaxf(mx, sv);
      }
  }
  mx = fmaxf(mx, __shfl_xor(mx, 32));
  const float msafe = (mx == NEG) ? 0.f : mx;
  const float alpha = __builtin_amdgcn_exp2f(a.m - msafe);
  a.m = mx;
  float ls = 0.f;
#pragma unroll
  for (int hf = 0; hf < 2; ++hf)
#pragma unroll
    for (int i = 0; i < 16; ++i) { const float pv = __builtin_amdgcn_exp2f(st[hf][i] - msafe); st[hf][i] = pv; ls += pv; }
  a.l = a.l * alpha + ls;
  if (!__all(alpha == 1.f)) {
#pragma unroll
    for (int c = 0; c < 4; ++c) a.o[c] *= alpha;
  }
  pv_tile(a, st[0], stg + STG_K, lane);
  pv_tile(a, st[1], stg + STG_K + 32 * VSTRIDE, lane);
}

template <class NEED, class MK>
DI void coop_attn(AttnAcc& a, const bf16x8 (&qf)[8], const u16* __restrict__ Kg, const u16* __restrict__ Vg,
                  unsigned long long blkmask, NEED need, MK mask, int tid, int lane) {
  if (!blkmask) return;
  const int r0 = tid >> 4, ch = tid & 15;
  const int ko = r0 * KSTR + ch * 16, vo = STG_K + r0 * VSTRIDE + ch * 16;
#define CA_POP(dst) do { if (blkmask) { dst = __builtin_ctzll(blkmask); blkmask &= blkmask - 1; } else dst = -1; } while (0)
#define CA_LOAD(S, jj) do { const size_t go_ = (size_t)(64 * (jj) + r0) * 128 + ch * 8; \
    S##0 = ldg8(Kg + go_); S##1 = ldg8(Kg + go_ + 32 * 128); S##2 = ldg8(Vg + go_); S##3 = ldg8(Vg + go_ + 32 * 128); } while (0)
#define CA_STORE(S, st_) do { char* s_ = (st_); *reinterpret_cast<bf16x8*>(s_ + ko) = S##0; *reinterpret_cast<bf16x8*>(s_ + ko + 32 * KSTR) = S##1; \
    *reinterpret_cast<bf16x8*>(s_ + vo) = S##2; *reinterpret_cast<bf16x8*>(s_ + vo + 32 * VSTRIDE) = S##3; } while (0)
#define CA_STEP(LD, ST) { CA_POP(j2); if (j2 >= 0) CA_LOAD(LD, j2); \
    if (need(j)) { int lo_, hi_; mask(j, lo_, hi_); coop_compute(a, qf, smem + cur * STG_B, lo_, hi_, lane); } \
    if (j1 >= 0) CA_STORE(ST, smem + (cur ^ 1) * STG_B); \
    __syncthreads(); \
    if (j1 < 0) break; \
    j = j1; j1 = j2; cur ^= 1; }
  bf16x8 A0, A1, A2, A3, B0, B1, B2, B3;
  int j, j1, j2, cur = 0;
  CA_POP(j); CA_POP(j1);
  CA_LOAD(A, j);
  CA_STORE(A, smem);
  if (j1 >= 0) CA_LOAD(A, j1);
  __syncthreads();
  for (;;) {
    CA_STEP(B, A)
    CA_STEP(A, B)
  }
#undef CA_POP
#undef CA_LOAD
#undef CA_STORE
#undef CA_STEP
}
DI const u16* kv4(const Params& p, int tensor, int b, int g) {
  return (const u16*)(p.ws + OFF_KV4) + (size_t)((tensor * 4 + b) * 2 + g) * 4096 * 128;
}

DI void win_block(const Params& p, int it, int tid, int wid, int lane) {
  const u16* proj = (const u16*)(p.ws + OFF_PROJ);
  const int q = it >> 3, bg = it & 7, b = bg >> 1, g = bg & 1, t0 = 32 * q;
  const int u = lane & 31, h = lane >> 5;
  const int hd = 8 * g + wid, t = t0 + u;
  const size_t tok = (size_t)b * S_ + t;
  bf16x8 qf[8];
  {
    const u16* qp = proj + tok * PS + C_QB + hd * 128 + 8 * h;
#pragma unroll
    for (int s = 0; s < 8; ++s) qf[s] = ldg8(qp + 16 * s);
  }
  const int lo = (t0 - 511 > 0 ? t0 - 511 : 0) >> 6, hi = (t0 + 31) >> 6;
  const unsigned long long blkmask = ((~0ull) >> (63 - hi)) & ((~0ull) << lo);
  AttnAcc a; attn_init(a);
  coop_attn(a, qf, kv4(p, 2, b, g), kv4(p, 3, b, g), blkmask,
            [&](int) -> bool { return true; },
            [&](int j, int& lo_, int& hi_) { const int l0 = t - 511 - 64 * j, h0 = t - 64 * j; lo_ = l0 > 0 ? l0 : 0; hi_ = h0 < 63 ? h0 : 63; }, tid, lane);
  const float lt = a.l + __shfl_xor(a.l, 32);
  {
    char* wl = smem + wid * 8704;
    cols_to_lds(a, __builtin_amdgcn_rcpf(lt), wl, lane);
    u16* owb = (u16*)(p.ws + OFF_R3) + ((size_t)b * S_ + t0) * 2048 + hd * 128;
    const int srow = lane >> 4, sch = lane & 15;
#pragma unroll
    for (int i = 0; i < 8; ++i) {
      const int row = srow + 4 * i;
      const uint4 v = lds_row_chunk(wl, row, sch);
      *reinterpret_cast<uint4*>(owb + (size_t)row * 2048 + sch * 8) = v;
    }
  }
  __syncthreads();
}

DI void slc_block(const Params& p, int it, int tid, int wid, int lane) {
  const u16* proj = (const u16*)(p.ws + OFF_PROJ);
  const float* psum = (const float*)(p.ws + OFF_PSUM);
  const int rr_ = it >> 8, ii = it & 255, qi = ii >> 3, bg = ii & 7;
  const int q = rr_ == 0 ? 127 - qi : (rr_ == 1 ? 64 + qi : (rr_ == 2 ? 63 - qi : qi));
  const int b = bg >> 1, g = bg & 1, t0 = 32 * q, blk_t = t0 >> 6;
  const int u = lane & 31, h = lane >> 5, tl = u >> 3, r = u & 7;
  const size_t tokbase = (size_t)b * S_;
  const int t = t0 + 4 * wid + tl, hd = 8 * g + r;
  const size_t tok = tokbase + t;
  bf16x8 qf[8];
  {
    const u16* qp = proj + tok * PS + C_QB + hd * 128 + 8 * h;
#pragma unroll
    for (int s = 0; s < 8; ++s) qf[s] = ldg8(qp + 16 * s);
  }
  unsigned long long msel[4];
#pragma unroll
  for (int k = 0; k < 4; ++k) {
    const size_t tk = tokbase + t0 + 4 * wid + k;
    const float* psrow = psum + (tk * 2 + g) * 256;
    const bool valid = lane <= blk_t;
    if (blk_t < 16) { msel[k] = __ballot(valid); continue; }
    unsigned key;
    {
      const int j = lane;
      const float4 pq = *reinterpret_cast<const float4*>(psrow + 4 * j);
      const float sm = (j > 0 ? psrow[4 * j - 1] : 0.f) + pq.x + pq.y + pq.z + pq.w;
      const bool forced = (j == 0) || (j == blk_t) || (j == blk_t - 1);
      key = valid ? __float_as_uint(sm + (forced ? 1e4f : 0.f)) : 0u;
    }
    unsigned thr = 0u;
    for (int bit = 30; bit >= 0; --bit) {
      const unsigned cand = thr | (1u << bit);
      if (__popcll(__ballot(valid && key >= cand)) >= 16) thr = cand;
    }
    const unsigned long long gt = __ballot(valid && key > thr), eq = __ballot(valid && key == thr);
    const int need = 16 - __popcll(gt);
    const int idx_eq = (int)__builtin_amdgcn_mbcnt_hi((unsigned)(eq >> 32), __builtin_amdgcn_mbcnt_lo((unsigned)eq, 0u));
    msel[k] = __ballot(valid && (key > thr || (key == thr && idx_eq < need)));
  }
  const unsigned long long mysel = tl == 0 ? msel[0] : (tl == 1 ? msel[1] : (tl == 2 ? msel[2] : msel[3]));
  const unsigned long long wunion = msel[0] | msel[1] | msel[2] | msel[3];
  unsigned long long* lu = reinterpret_cast<unsigned long long*>(smem + LDS_UNION);
  { int w2 = wid; asm volatile("" : "+v"(w2)); if (lane == 0) lu[w2] = wunion; }
  __syncthreads();
  const unsigned long long bunion = lu[0] | lu[1] | lu[2] | lu[3] | lu[4] | lu[5] | lu[6] | lu[7];
  AttnAcc a; attn_init(a);
  coop_attn(a, qf, kv4(p, 0, b, g), kv4(p, 1, b, g), bunion,
            [&](int j) -> bool { return ((wunion >> j) & 1ull) != 0; },
            [&](int j, int& lo_, int& hi_) { const bool sel = ((mysel >> j) & 1ull) != 0; const int h0 = t - 64 * j; lo_ = sel ? 0 : 1000; hi_ = sel ? (h0 < 63 ? h0 : 63) : -1000; }, tid, lane);
  const float lt = a.l + __shfl_xor(a.l, 32);
  {
    const float inv = __builtin_amdgcn_rcpf(lt);
    const u16* gp = proj + tok * PS + C_GN + hd * 3;
    const float g0 = sigmoidf_(bf2f(gp[0])), g1 = sigmoidf_(bf2f(gp[1])) * inv, g2 = sigmoidf_(bf2f(gp[2]));
    char* wl = smem + wid * 8704;
    {
      int l2 = lane; asm volatile("" : "+v"(l2));
      const uint2* of = reinterpret_cast<const uint2*>(p.ws + OFF_R2) + ((((size_t)(b * 2 + g) * 128 + q) * 8 + wid) * 16) * 64 + l2;
#pragma unroll
      for (int c = 0; c < 4; ++c)
#pragma unroll
        for (int g4 = 0; g4 < 4; ++g4) {
          const uint2 w = of[(c * 4 + g4) * 64];
          a.o[c][4 * g4 + 0] = a.o[c][4 * g4 + 0] * g1 + g0 * bflo(w.x);
          a.o[c][4 * g4 + 1] = a.o[c][4 * g4 + 1] * g1 + g0 * bfhi(w.x);
          a.o[c][4 * g4 + 2] = a.o[c][4 * g4 + 2] * g1 + g0 * bflo(w.y);
          a.o[c][4 * g4 + 3] = a.o[c][4 * g4 + 3] * g1 + g0 * bfhi(w.y);
        }
    }
    cols_to_lds(a, 1.f, wl, lane);
    if (h == 0) reinterpret_cast<float2*>(wl + 8192)[u] = make_float2(0.f, g2);
    int l3 = lane; asm volatile("" : "+v"(l3));
    const int srow = l3 >> 4, sch = l3 & 15;
#pragma unroll
    for (int i = 0; i < 8; ++i) {
      const int row = srow + 4 * i;
      const uint4 v = lds_row_chunk(wl, row, sch);
      const float2 gg = reinterpret_cast<const float2*>(wl + 8192)[row];
      const size_t ro = (tokbase + t0 + 4 * wid + (row >> 3)) * 2048 + (size_t)(8 * g + (row & 7)) * 128 + sch * 8;
      const uint4 ww = *reinterpret_cast<const uint4*>((const u16*)(p.ws + OFF_R3) + ro);
      uint4 y;
      y.x = pk2(bflo(v.x) + gg.y * bflo(ww.x), bfhi(v.x) + gg.y * bfhi(ww.x));
      y.y = pk2(bflo(v.y) + gg.y * bflo(ww.y), bfhi(v.y) + gg.y * bfhi(ww.y));
      y.z = pk2(bflo(v.z) + gg.y * bflo(ww.z), bfhi(v.z) + gg.y * bfhi(ww.z));
      y.w = pk2(bflo(v.w) + gg.y * bflo(ww.w), bfhi(v.w) + gg.y * bfhi(ww.w));
      *reinterpret_cast<uint4*>((u16*)(p.ws + OFF_YB) + ro) = y;
    }
  }
  __syncthreads();
}

DI void dil_merge(const Params& p, int gw, int nw, int lane) {
  const u16* og = (const u16*)(p.ws + OFF_OG);
  const float* lse = (const float*)(p.ws + OFF_LSE);
  u16* ya = (u16*)(p.ws + OFF_YA);
  const int hh = lane >> 4, d0 = (lane & 15) * 8;
  for (int tok = gw; tok < T_; tok += nw) {
    const float l0 = lse[((size_t)0 * T_ + tok) * 4 + hh], l1 = lse[((size_t)1 * T_ + tok) * 4 + hh], l2 = lse[((size_t)2 * T_ + tok) * 4 + hh];
    const float mx = fmaxf(l0, fmaxf(l1, l2));
    float w0 = __expf(l0 - mx), w1 = __expf(l1 - mx), w2 = __expf(l2 - mx);
    const float inv = 1.f / (w0 + w1 + w2);
    w0 *= inv; w1 *= inv; w2 *= inv;
    const uint4 a0 = *reinterpret_cast<const uint4*>(og + ((size_t)0 * T_ + tok) * 512 + hh * 128 + d0);
    const uint4 a1 = *reinterpret_cast<const uint4*>(og + ((size_t)1 * T_ + tok) * 512 + hh * 128 + d0);
    const uint4 a2 = *reinterpret_cast<const uint4*>(og + ((size_t)2 * T_ + tok) * 512 + hh * 128 + d0);
    uint4 o;
    o.x = pk2(w0 * bflo(a0.x) + w1 * bflo(a1.x) + w2 * bflo(a2.x), w0 * bfhi(a0.x) + w1 * bfhi(a1.x) + w2 * bfhi(a2.x));
    o.y = pk2(w0 * bflo(a0.y) + w1 * bflo(a1.y) + w2 * bflo(a2.y), w0 * bfhi(a0.y) + w1 * bfhi(a1.y) + w2 * bfhi(a2.y));
    o.z = pk2(w0 * bflo(a0.z) + w1 * bflo(a1.z) + w2 * bflo(a2.z), w0 * bfhi(a0.z) + w1 * bfhi(a1.z) + w2 * bfhi(a2.z));
    o.w = pk2(w0 * bflo(a0.w) + w1 * bflo(a1.w) + w2 * bflo(a2.w), w0 * bfhi(a0.w) + w1 * bfhi(a1.w) + w2 * bfhi(a2.w));
    *reinterpret_cast<uint4*>(ya + (size_t)tok * 512 + hh * 128 + d0) = o;
  }
}

DI float gelu_tanh(float x) {
  const float y = 0.7978845608028654f * (x + 0.044715f * x * x * x);
  return 0.5f * x * (1.f + tanhf(y));
}
constexpr int GSTR = 528;
DI void cmp_mlp_block(const Params& p, int layer, int item, int wid, int lane) {
  const u16* proj = (const u16*)(p.ws + OFF_PROJ);
  const int kv = item >> 6, rt = item & 63;
  const int g = rt >> 5, b = (rt >> 3) & 3, c0 = (rt & 7) * 32;
  const int u = lane & 31, h = lane >> 5;
  const u16* w1t = (const u16*)(p.ws + (kv ? OFF_W1V_T : OFF_W1K_T));
  const u16* w2t = (const u16*)(p.ws + (kv ? OFF_W2V_T : OFF_W2K_T));
  const float* pos = (kv ? p.cpv : p.cpk) + (size_t)layer * 32 * 128;
  const int ccol = (kv ? C_VC : C_KC) + g * 128;
  f32x16 hacc = zero16();
  {
    const int tokb = b * S_ + 16 * c0;
    for (int idx = wid * 64 + lane; idx < 528 * 16; idx += NTHREADS) {
      const int r = idx >> 4, ch = idx & 15;
      int tk = tokb + r; tk = tk > T_ - 1 ? T_ - 1 : tk;
      const bf16x8 v = ldg8(proj + (size_t)tk * PS + ccol + ch * 8);
      *reinterpret_cast<bf16x8*>(smem + ((r & 15) * 33 + (r >> 4)) * 272 + ch * 16) = v;
    }
  }
  __syncthreads();
  const u16* wfr = w1t + (size_t)wid * 256 * 64 * 8 + lane * 8;
#pragma unroll 2
  for (int l = 0; l < 32; ++l) {
    bf16x8 wf[8];
#pragma unroll
    for (int s2 = 0; s2 < 8; ++s2) wf[s2] = ldg8(wfr + (size_t)(l * 8 + s2) * 64 * 8);
    const char* drow = smem + ((l & 15) * 33 + (l >> 4) + u) * 272 + 16 * h;
    const float* prow = pos + l * 128 + 8 * h;
#pragma unroll
    for (int s2 = 0; s2 < 8; ++s2) {
      const uint4 dv = *reinterpret_cast<const uint4*>(drow + 32 * s2);
      const float4 p0 = *reinterpret_cast<const float4*>(prow + 16 * s2), p1 = *reinterpret_cast<const float4*>(prow + 16 * s2 + 4);
      typedef __attribute__((ext_vector_type(4))) unsigned u32x4;
      u32x4 w;
      w[0] = pk2(bflo(dv.x) + p0.x, bfhi(dv.x) + p0.y);
      w[1] = pk2(bflo(dv.y) + p0.z, bfhi(dv.y) + p0.w);
      w[2] = pk2(bflo(dv.z) + p1.x, bfhi(dv.z) + p1.y);
      w[3] = pk2(bflo(dv.w) + p1.z, bfhi(dv.w) + p1.w);
      const bf16x8 df = __builtin_bit_cast(bf16x8, w);
      hacc = MFMA32(wf[s2], df, hacc);
    }
  }
  __syncthreads();
  char* gl = smem;
#pragma unroll
  for (int g4 = 0; g4 < 4; ++g4) {
    uint2 w;
    w.x = pk2(gelu_tanh(hacc[4 * g4 + 0]), gelu_tanh(hacc[4 * g4 + 1]));
    w.y = pk2(gelu_tanh(hacc[4 * g4 + 2]), gelu_tanh(hacc[4 * g4 + 3]));
    *reinterpret_cast<uint2*>(gl + u * GSTR + (32 * wid + 8 * g4 + 4 * h) * 2) = w;
  }
  __syncthreads();
  if (wid < 2) {
    f32x16 o0 = zero16(), o1 = zero16();
#pragma unroll
    for (int ks = 0; ks < 16; ++ks) {
      const bf16x8 gf = *reinterpret_cast<const bf16x8*>(gl + u * GSTR + (16 * ks + 8 * h) * 2);
      const bf16x8 wa = ldg8(w2t + (size_t)(32 * wid + u) * 256 + 16 * ks + 8 * h);
      const bf16x8 wb = ldg8(w2t + (size_t)(32 * (wid + 2) + u) * 256 + 16 * ks + 8 * h);
      o0 = MFMA32(wa, gf, o0);
      o1 = MFMA32(wb, gf, o1);
    }
    const int cidx = c0 + u;
    if (kv == 0) {
      int tk = b * S_ + 16 * cidx + 31; tk = tk > T_ - 1 ? T_ - 1 : tk;
      const float2* cs = (const float2*)(p.ws + OFF_CS) + (size_t)tk * 64;
#pragma unroll
      for (int i = 0; i < 16; ++i) {
        const float2 cc = cs[32 * wid + crow(i, h)];
        const float x1 = o0[i], x2 = o1[i];
        o0[i] = x1 * cc.x - x2 * cc.y;
        o1[i] = x2 * cc.x + x1 * cc.y;
      }
    }
    u16* dst = (u16*)(p.ws + (kv ? OFF_VCMP : OFF_KCMP)) + ((size_t)(b * 256 + cidx) * 2 + g) * 128;
#pragma unroll
    for (int g4 = 0; g4 < 4; ++g4) {
      uint2 w;
      w.x = pk2(o0[4 * g4 + 0], o0[4 * g4 + 1]); w.y = pk2(o0[4 * g4 + 2], o0[4 * g4 + 3]);
      *reinterpret_cast<uint2*>(dst + 32 * wid + 8 * g4 + 4 * h) = w;
      w.x = pk2(o1[4 * g4 + 0], o1[4 * g4 + 1]); w.y = pk2(o1[4 * g4 + 2], o1[4 * g4 + 3]);
      *reinterpret_cast<uint2*>(dst + 32 * (wid + 2) + 8 * g4 + 4 * h) = w;
    }
  }
  __syncthreads();
}

constexpr int PH_PER_LAYER = 10;
constexpr int N_PHASES = 2 * PH_PER_LAYER + 1;

DI void run_phase(const Params& p, int ph, int tid, int rep, const int bid, const int nb) {
  const int lane = tid & 63, wid = tid >> 6;
  const int gw = bid * 8 + wid, nw = nb * 8;
  char* vlds = smem + wid * (32 * 272 + VTILE_B);
  if (ph == 2 * PH_PER_LAYER) { rmsnorm_f32_inplace(p.out, p.ln_final, gw, nw, lane); return; }
  const int layer = ph / PH_PER_LAYER, sub = ph % PH_PER_LAYER;
  const float* xin = layer == 0 ? p.x : p.out;
  switch (sub) {
    case 0: {
      {
        const float* w = p.w_in + (size_t)layer * 2048 * NIN;
        auto src = [=](int np) -> const float* { const int cp = np & 127; const int n = (np & ~127) + ((cp >> 5) * 16 + (cp & 15)) + 64 * ((cp >> 4) & 1);
          return n < 8192 ? w + n : (n < 12288 ? w + n + 48 : (n < 12336 ? w + n - 4096 : nullptr)); };
        tconv((u16*)(p.ws + OFF_WIN_T), 2048, NINP, NIN, src, bid, nb, tid);
      }
      { const float* w = p.woa + (size_t)layer * 512 * 2048; auto src = [=](int n) -> const float* { return w + n; };
        tconv((u16*)(p.ws + OFF_WOA_T), 512, 2048, 2048, src, bid, nb, tid); }
      { const float* w = p.wob + (size_t)layer * 2048 * 2048; auto src = [=](int n) -> const float* { return w + n; };
        tconv((u16*)(p.ws + OFF_WOB_T), 2048, 2048, 2048, src, bid, nb, tid); }
      { const float* w = p.wo + (size_t)layer * 2048 * 2048; auto src = [=](int n) -> const float* { return w + n; };
        tconv((u16*)(p.ws + OFF_WO_T), 2048, 2048, 2048, src, bid, nb, tid); }
      conv_w1frag((u16*)(p.ws + OFF_W1K_T), p.w1k + (size_t)layer * 4096 * 256, bid * NTHREADS + tid, nb * NTHREADS);
      conv_w1frag((u16*)(p.ws + OFF_W1V_T), p.w1v + (size_t)layer * 4096 * 256, bid * NTHREADS + tid, nb * NTHREADS);
      { const float* w = p.w2k + (size_t)layer * 256 * 128; auto src = [=](int n) -> const float* { return w + n; };
        tconv((u16*)(p.ws + OFF_W2K_T), 256, 128, 128, src, bid, nb, tid); }
      { const float* w = p.w2v + (size_t)layer * 256 * 128; auto src = [=](int n) -> const float* { return w + n; };
        tconv((u16*)(p.ws + OFF_W2V_T), 256, 128, 128, src, bid, nb, tid); }
      if (layer == 0) {
        float2* cs = (float2*)(p.ws + OFF_CS);
        const float inv = powf(10000.0f, -2.0f * (float)lane / 128.0f);
        for (int tok = gw; tok < T_; tok += nw) {
          const float ang = (float)p.pos[tok] * inv;
          float sn, cn; sincosf(ang, &sn, &cn);
          cs[(size_t)tok * 64 + lane] = make_float2(cn, sn);
        }
      }
      rmsnorm_bf16(xin, p.ln_mix + (size_t)layer * 2048, (u16*)(p.ws + OFF_R2), gw, nw, lane);
    } break;
    case 1: gemm_proj(p, bid, nb, tid); break;
    case 2: {
      for (int it = bid; it < 128; it += nb) cmp_mlp_block(p, layer, it, wid, lane);
      if (nb == 256) {
        if (gw < 1024) { for (int k = 0; k < 2; ++k) dil_item(p, gw * 2 + k, vlds, lane); }
        else { for (int k = 0; k < 4; ++k) dil_item(p, 2048 + (gw - 1024) * 4 + k, vlds, lane); }
      } else {
        for (int it = gw; it < 6144; it += nw) dil_item(p, it, vlds, lane);
      }
    } break;
    case 3: {
      for (int it = bid; it < 1024; it += nb) win_block(p, it, tid, wid, lane);
      for (int sit = bid; sit < 256; sit += nb) cmp_block(p, sit, tid, wid, lane);
    } break;
    case 4: {
      for (int it = bid; it < 1024; it += nb) slc_block(p, it, tid, wid, lane);
      dil_merge(p, gw, nw, lane);
    } break;
    case 5: gemm_merge(p, bid, nb, tid); break;
    case 6: gemm_resid((const u16*)(p.ws + OFF_R3), (const u16*)(p.ws + OFF_WO_T), 2048, xin, rep ? (float*)(p.ws + OFF_PROJ) : p.out, bid, nb, tid); break;
    case 7: {
      {
        const float* wgp = p.wg + (size_t)layer * 2048 * DFF; const float* wup = p.wu + (size_t)layer * 2048 * DFF;
        auto src = [=](int n) -> const float* { const int pt = n >> 8, r = n & 255; return r < 128 ? wgp + pt * 128 + r : wup + pt * 128 + (r - 128); };
        tconv((u16*)(p.ws + OFF_WGU_T), 2048, 11264, DFF, src, bid, nb, tid);
      }
      { const float* w = p.wd + (size_t)layer * DFF * 2048; auto src = [=](int n) -> const float* { return w + n; };
        tconv((u16*)(p.ws + OFF_WD_T), DFF, 2048, 2048, src, bid, nb, tid); }
      rmsnorm_bf16(p.out, p.ln_ffn + (size_t)layer * 2048, (u16*)(p.ws + OFF_R2), gw, nw, lane);
    } break;
    case 8: gemm_gateup(p, bid, nb, tid); break;
    case 9: gemm_resid((const u16*)(p.ws + OFF_PROJ), (const u16*)(p.ws + OFF_WD_T), DFF, p.out, rep ? (float*)(p.ws + OFF_R2) : p.out, bid, nb, tid); break;
  }
}

DI unsigned bar_ld(unsigned* p) { return __hip_atomic_load(p, __ATOMIC_RELAXED, __HIP_MEMORY_SCOPE_AGENT); }
DI unsigned bar_add(unsigned* p) { return __hip_atomic_fetch_add(p, 1u, __ATOMIC_RELAXED, __HIP_MEMORY_SCOPE_AGENT); }
DI void fast_grid_sync(unsigned* bar, const unsigned k, const unsigned nb, const unsigned bid, int tid) {
  asm volatile("s_waitcnt vmcnt(0) lgkmcnt(0)" ::: "memory");
  __syncthreads();
  if (tid == 0) {
    __builtin_amdgcn_fence(__ATOMIC_RELEASE, "agent");
    asm volatile("s_waitcnt vmcnt(0)" ::: "memory");
    const unsigned g = bid & 7u, gsz = nb >> 3;
    unsigned spins = 0;
    const unsigned old = bar_add(bar + 64 * g);
    bool last = false;
    if (old + 1u == k * gsz) last = (bar_add(bar + 64 * 16) + 1u == k * 8u);
    if (!last) while (bar_ld(bar + 64 * 16) < k * 8u && ++spins < (1u << 22)) __builtin_amdgcn_s_sleep(1);
    __builtin_amdgcn_fence(__ATOMIC_ACQUIRE, "agent");
    asm volatile("s_waitcnt vmcnt(0)" ::: "memory");
  }
  __syncthreads();
}

__global__ void __launch_bounds__(NTHREADS) fwd_kernel(Params p, int ph0, int ph1) {
  if (ph1 < 0) cg::this_grid().sync();
  const int widx = __builtin_amdgcn_readfirstlane((int)(threadIdx.x >> 6));
  unsigned nbar = 0;
  for (int pi = ph0; pi < ph1; ++pi) {
    int ph = pi, rep = 0;
    if (N_PROBE > 0 && pi >= N_PHASES) { ph = (pi == N_PHASES) ? PROBE_A : PROBE_B; rep = 1; }
    int tid;
    asm volatile("v_mbcnt_lo_u32_b32 %0, -1, 0\n\tv_mbcnt_hi_u32_b32 %0, -1, %0\n\tv_lshl_add_u32 %0, %1, 6, %0" : "=&v"(tid) : "s"(widx));
    int bid_ = blockIdx.x, nb_ = gridDim.x;
    asm volatile("" : "+s"(bid_), "+s"(nb_));
    run_phase(p, ph, tid, rep, bid_, nb_);
    if (pi + 1 < ph1) {
      ++nbar; fast_grid_sync(reinterpret_cast<unsigned*>(p.ws + OFF_BAR), nbar, gridDim.x, blockIdx.x, tid);
    }
  }
}

extern "C" void kernel_launch(void* const* d_in, const int* in_sizes, int n_in, void* d_out, int out_size, void* d_ws,
                              size_t ws_size, hipStream_t stream) {
  if (n_in != 18 || ws_size < WS_END) { fprintf(stderr, "kernel_launch: unexpected n_in %d or ws_size %zu < %zu\n", n_in, ws_size, (size_t)WS_END); return; }
  Params p{};
  p.x = (const float*)d_in[0]; p.pos = (const int*)d_in[1]; p.ln_mix = (const float*)d_in[2]; p.w_in = (const float*)d_in[3];
  p.cpk = (const float*)d_in[4]; p.cpv = (const float*)d_in[5]; p.w1k = (const float*)d_in[6]; p.w2k = (const float*)d_in[7];
  p.w1v = (const float*)d_in[8]; p.w2v = (const float*)d_in[9]; p.woa = (const float*)d_in[10]; p.wob = (const float*)d_in[11];
  p.wo = (const float*)d_in[12]; p.ln_ffn = (const float*)d_in[13]; p.wg = (const float*)d_in[14]; p.wu = (const float*)d_in[15];
  p.wd = (const float*)d_in[16]; p.ln_final = (const float*)d_in[17];
  p.out = (float*)d_out; p.ws = (char*)d_ws;
  static int grid_blocks = 0;
  if (!grid_blocks) {
    int dev = 0, cus = 0, per_cu = 0;
    hipGetDevice(&dev);
    hipDeviceGetAttribute(&cus, hipDeviceAttributeMultiprocessorCount, dev);
    hipOccupancyMaxActiveBlocksPerMultiprocessor(&per_cu, fwd_kernel, NTHREADS, 0);
    if (per_cu < 1) per_cu = 1;
    if (per_cu > 1) per_cu = 1;
    grid_blocks = cus * per_cu;
    if (grid_blocks % 8) grid_blocks -= grid_blocks % 8;
  }
#if MULTI_LAUNCH
  for (int ph = 0; ph < N_PHASES; ++ph) {
    hipLaunchKernelGGL(fwd_kernel, dim3(grid_blocks), dim3(NTHREADS), 0, stream, p, ph, ph + 1);
  }
#else
  int ph0 = 0, ph1 = N_PHASES + N_PROBE;
  (void)hipMemsetAsync((char*)d_ws + OFF_BAR, 0, 8192, stream);
  void* args[] = {&p, &ph0, &ph1};
  hipError_t e = hipLaunchCooperativeKernel((void*)fwd_kernel, dim3(grid_blocks), dim3(NTHREADS), args, 0, stream);
  if (e != hipSuccess) fprintf(stderr, "cooperative launch failed: %s (grid %d)\n", hipGetErrorString(e), grid_blocks);
#endif
}
```
